# Optimizing an MI355X kernel written in HIP

```python
import math
import jax, jax.numpy as jnp
from jax import lax
import numpy as np

D_MODEL = 1024
BATCH = 16
SEQ = 2048
DEPTH = 1

HEAD_DIM = 64
HEADS_PER_GROUP = 4
DILATION_GROUPS = ((128, 1), (512, 4), (2048, 16))
N_ATT_GROUPS = len(DILATION_GROUPS)
N_ATT_HEADS = N_ATT_GROUPS * HEADS_PER_GROUP
ATT_WIDTH = N_ATT_HEADS * HEAD_DIM
ATT_OUT_WIDTH = HEADS_PER_GROUP * HEAD_DIM
BLOCK = 128
POOL_WINDOWS = (2, 4, 8, 16)
N_POOL_GROUPS = len(POOL_WINDOWS)
POOL_WIDTH = D_MODEL
POOL_GROUP_WIDTH = POOL_WIDTH // N_POOL_GROUPS
IN_WIDTH = 3 * ATT_WIDTH + POOL_WIDTH + 2 * D_MODEL
D_FF = -(-8 * D_MODEL // (3 * 256)) * 256
N_ADA = 6
DEEPNORM_ALPHA = (2.0 * DEPTH) ** 0.25
DEEPNORM_BETA = (8.0 * DEPTH) ** -0.25
LN_EPS = 1e-5

kernel_name = "hybrid_dilated_attn_pool_deepnorm_adaln"


def alibi_slopes(n):
    def pow2_slopes(m):
        start = 2.0 ** (-8.0 / m)
        return [start ** (i + 1) for i in range(m)]
    if math.log2(n).is_integer():
        s = pow2_slopes(n)
    else:
        c = 2 ** math.floor(math.log2(n))
        s = pow2_slopes(c) + pow2_slopes(2 * c)[0::2][: n - c]
    return jnp.asarray(np.array(sorted(s, reverse=True), dtype=np.float32))


def layer_norm(x, g, b):
    xf = x.astype(jnp.float32)
    mu = jnp.mean(xf, axis=-1, keepdims=True)
    var = jnp.mean(jnp.square(xf - mu), axis=-1, keepdims=True)
    y = (xf - mu) * lax.rsqrt(var + LN_EPS) * g.astype(jnp.float32) + b.astype(jnp.float32)
    return y.astype(x.dtype)


def dilated_window_attention(q, k, v, window, dilation, slopes):
    B, S, H, Dh = q.shape
    steps = window // dilation
    chunk = dilation * BLOCK
    s_pad = -(-S // chunk) * chunk
    L = s_pad // dilation
    nb = L // BLOCK

    def to_blocks(t):
        t = jnp.pad(t, ((0, 0), (0, s_pad - S), (0, 0), (0, 0)))
        t = t.reshape(B, L, dilation, H, Dh).transpose(0, 2, 3, 1, 4)
        return t.reshape(B, dilation, H, nb, BLOCK, Dh)

    def with_prev(t):
        prev = jnp.pad(t[:, :, :, :-1], ((0, 0), (0, 0), (0, 0), (1, 0), (0, 0), (0, 0)))
        return jnp.concatenate([prev, t], axis=4)

    qb = to_blocks(q)
    kw = with_prev(to_blocks(k))
    vw = with_prev(to_blocks(v))

    scores = jnp.einsum('brhnqd,brhnkd->brhnqk', qb, kw).astype(jnp.float32) * (1.0 / math.sqrt(Dh))
    qi = jnp.arange(BLOCK) + BLOCK
    kj = jnp.arange(2 * BLOCK)
    diff = qi[:, None] - kj[None, :]
    key_sub = jnp.arange(nb)[:, None, None] * BLOCK - BLOCK + kj[None, None, :]
    valid = (diff >= 0)[None] & (diff <= steps)[None] & (key_sub >= 0)
    bias = -slopes.astype(jnp.float32)[:, None, None] * (diff * dilation).astype(jnp.float32)[None]
    scores = scores + bias[None, None, :, None]
    scores = jnp.where(valid[None, None, None], scores, -jnp.inf)
    m = jnp.max(scores, axis=-1, keepdims=True)
    p = jnp.exp(scores - m)
    denom = jnp.sum(p, axis=-1, keepdims=True)
    out = jnp.einsum('brhnqk,brhnkd->brhnqd', p, vw.astype(jnp.float32)) / denom
    lse = (m + jnp.log(denom))[..., 0]

    out = out.reshape(B, dilation, H, L, Dh).transpose(0, 3, 1, 2, 4).reshape(B, s_pad, H, Dh)[:, :S]
    lse = lse.reshape(B, dilation, H, L).transpose(0, 3, 1, 2).reshape(B, s_pad, H)[:, :S]
    return out, lse


def causal_multiscale_pool(u):
    B, S, G, C = u.shape
    uf = u.astype(jnp.float32)
    cs = jnp.cumsum(uf, axis=1)
    pos = jnp.arange(S)
    outs = []
    for g, w in enumerate(POOL_WINDOWS):
        csg = cs[:, :, g]
        lagged = jnp.pad(csg, ((0, 0), (w, 0), (0, 0)))[:, :S]
        count = jnp.minimum(pos + 1, w).astype(jnp.float32)[None, :, None]
        outs.append((csg - lagged) / count)
    return jnp.stack(outs, axis=2) - uf


def setup_inputs(seed: int = 0) -> dict:
    key = jax.random.key(seed)
    ks = jax.random.split(key, 20)
    f32 = jnp.float32
    nrm = lambda k, shape, s: jax.random.normal(k, shape, f32) * s
    w_in = nrm(ks[3], (DEPTH, D_MODEL, IN_WIDTH), D_MODEL ** -0.5)
    w_in = w_in.at[:, :, 2 * ATT_WIDTH:3 * ATT_WIDTH].multiply(DEEPNORM_BETA)
    return {
        "x": nrm(ks[0], (BATCH, SEQ, D_MODEL), 1.0),
        "c": nrm(ks[1], (BATCH, D_MODEL), 1.0),
        "w_ada": nrm(ks[2], (DEPTH, D_MODEL, N_ADA * D_MODEL), 0.5 * D_MODEL ** -0.5),
        "b_ada": nrm(ks[4], (DEPTH, N_ADA * D_MODEL), 0.02),
        "w_in": w_in,
        "w_branch_att": nrm(ks[5], (DEPTH, ATT_OUT_WIDTH, D_MODEL), ATT_OUT_WIDTH ** -0.5),
        "w_pool_group": nrm(ks[6], (DEPTH, N_POOL_GROUPS, POOL_GROUP_WIDTH, POOL_GROUP_WIDTH), POOL_GROUP_WIDTH ** -0.5),
        "pool_scale": 1.0 + nrm(ks[7], (DEPTH, POOL_WIDTH), 0.1),
        "w_branch_pool": nrm(ks[8], (DEPTH, POOL_WIDTH, D_MODEL), POOL_WIDTH ** -0.5),
        "w_out": nrm(ks[9], (DEPTH, D_MODEL, D_MODEL), DEEPNORM_BETA * D_MODEL ** -0.5),
        "ln1_g": 1.0 + nrm(ks[10], (DEPTH, D_MODEL), 0.02),
        "ln1_b": nrm(ks[11], (DEPTH, D_MODEL), 0.02),
        "w_gate": nrm(ks[12], (DEPTH, D_MODEL, D_FF), D_MODEL ** -0.5),
        "w_up": nrm(ks[13], (DEPTH, D_MODEL, D_FF), D_MODEL ** -0.5),
        "w_down": nrm(ks[14], (DEPTH, D_FF, D_MODEL), DEEPNORM_BETA * D_FF ** -0.5),
        "ln2_g": 1.0 + nrm(ks[15], (DEPTH, D_MODEL), 0.02),
        "ln2_b": nrm(ks[16], (DEPTH, D_MODEL), 0.02),
    }


def reference(x, c, w_ada, b_ada, w_in, w_branch_att, w_pool_group, pool_scale, w_branch_pool,
              w_out, ln1_g, ln1_b, w_gate, w_up, w_down, ln2_g, ln2_b):
    B, S, D = x.shape
    slopes = alibi_slopes(N_ATT_HEADS).reshape(N_ATT_GROUPS, HEADS_PER_GROUP)
    split_at = [ATT_WIDTH, 2 * ATT_WIDTH, 3 * ATT_WIDTH, 3 * ATT_WIDTH + POOL_WIDTH,
                3 * ATT_WIDTH + POOL_WIDTH + D_MODEL]
    for l in range(DEPTH):
        mod = (jax.nn.silu(c) @ w_ada[l] + b_ada[l])[:, None, :]
        sh1, sc1, g1, sh2, sc2, g2 = jnp.split(mod, N_ADA, axis=-1)

        h = x * (1.0 + sc1) + sh1
        proj = h @ w_in[l]
        q, k, v, pool_in, ga, gb = jnp.split(proj, split_at, axis=-1)
        q = q.reshape(B, S, N_ATT_GROUPS, HEADS_PER_GROUP, HEAD_DIM)
        k = k.reshape(B, S, N_ATT_GROUPS, HEADS_PER_GROUP, HEAD_DIM)
        v = v.reshape(B, S, N_ATT_GROUPS, HEADS_PER_GROUP, HEAD_DIM)

        outs, lses = [], []
        for g, (window, dilation) in enumerate(DILATION_GROUPS):
            o, s = dilated_window_attention(q[:, :, g], k[:, :, g], v[:, :, g], window, dilation, slopes[g])
            outs.append(o)
            lses.append(s)
        mix_w = jax.nn.softmax(jnp.stack(lses, axis=0), axis=0)
        att = jnp.sum(mix_w[..., None] * jnp.stack(outs, axis=0), axis=0)
        att = att.reshape(B, S, ATT_OUT_WIDTH).astype(x.dtype)
        branch_a = att @ w_branch_att[l]

        u = pool_in.reshape(B, S, N_POOL_GROUPS, POOL_GROUP_WIDTH)
        pm = causal_multiscale_pool(u).astype(x.dtype)
        pg = jnp.einsum('bsgc,gce->bsge', pm, w_pool_group[l]).reshape(B, S, POOL_WIDTH) * pool_scale[l]
        branch_b = pg @ w_branch_pool[l]

        merged = jax.nn.sigmoid(ga) * branch_a + jax.nn.sigmoid(gb) * branch_b
        mixer_out = merged @ w_out[l]
        x = layer_norm(DEEPNORM_ALPHA * x + g1 * mixer_out, ln1_g[l], ln1_b[l])

        h2 = x * (1.0 + sc2) + sh2
        ffn = (jax.nn.silu(h2 @ w_gate[l]) * (h2 @ w_up[l])) @ w_down[l]
        x = layer_norm(DEEPNORM_ALPHA * x + g2 * ffn, ln2_g[l], ln2_b[l])
    return x
```

```cpp
#include <hip/hip_runtime.h>
#include <hip/hip_cooperative_groups.h>
#include <cstdio>
#include <cstdint>
namespace cg = cooperative_groups;

#define LAS __attribute__((address_space(3)))
typedef unsigned short bf16_t;
typedef short bf16x8 __attribute__((ext_vector_type(8)));
typedef short s16x4 __attribute__((ext_vector_type(4)));
typedef float f32x4 __attribute__((ext_vector_type(4)));
typedef unsigned u32x4 __attribute__((ext_vector_type(4)));
typedef unsigned u32x2 __attribute__((ext_vector_type(2)));

constexpr int DM = 1024, NB = 16, SEQ = 2048, T = NB * SEQ, INW = 5376, DFF = 2816, NMOD = 6144;
constexpr float LN_EPS = 1e-5f;
constexpr float ALPHA = 1.189207115002721f;
constexpr int NWAVES = 8, NTHR = 512;
constexpr int LDS_BYTES = 147456;

constexpr size_t MiB = 1u << 20;
constexpr size_t WS_WIN = 1 * MiB;
constexpr size_t WS_WA = WS_WIN + 11 * MiB;
constexpr size_t WS_WPG = WS_WA + 1 * MiB;
constexpr size_t WS_WBP = WS_WPG + 1 * MiB;
constexpr size_t WS_WO = WS_WBP + 2 * MiB;
constexpr size_t WS_WGU = WS_WO + 2 * MiB;
constexpr size_t WS_WD = WS_WGU + 11 * MiB;
constexpr size_t WS_MOD = WS_WD + 6 * MiB;
constexpr size_t WS_LSE = WS_MOD + 1 * MiB;
constexpr size_t WS_B = 40 * MiB;
constexpr size_t WS_C = 104 * MiB;
constexpr size_t WS_D = 248 * MiB;
constexpr size_t WS_E = 312 * MiB;
constexpr size_t WS_F = 440 * MiB;
constexpr size_t WS_G = 488 * MiB;
constexpr size_t WS_END = 504 * MiB;
static_assert(WS_LSE + 2 * MiB <= WS_B, "ws map");

typedef float f32x2_t __attribute__((ext_vector_type(2)));
typedef __bf16 bf16x2_t __attribute__((ext_vector_type(2)));
__device__ __forceinline__ unsigned cvt_pk_bf16(float lo, float hi) { const f32x2_t v = {lo, hi}; const bf16x2_t b = __builtin_convertvector(v, bf16x2_t); return __builtin_bit_cast(unsigned, b); }
__device__ __forceinline__ float wave_sum(float v) {
#pragma unroll
    for (int o = 1; o < 64; o <<= 1) v += __shfl_xor(v, o);
    return v;
}
__device__ __forceinline__ float fast_sigmoid(float v) { return __builtin_amdgcn_rcpf(1.0f + __expf(-v)); }
__device__ __forceinline__ int fresh_tid() { int t = threadIdx.x; asm volatile("" : "+v"(t)); return t; }
__device__ __forceinline__ float bf2f(unsigned short h) { return __uint_as_float(((unsigned)h) << 16); }

namespace pg8 {
constexpr int BM = 256, BK = 64, HALF = 128, HTB = HALF * BK * 2, STAGE_BYTES = 8 * HTB, NXCD = 8, WGM = 8;
__host__ __device__ __forceinline__ int lds_byte(int r, int c) { const int st = (r >> 4) * 2 + (c >> 5), rr = r & 15, cc = c & 31, ob = rr * 64 + cc * 2; return st * 1024 + (ob ^ (((ob >> 9) & 1) << 5)); }
__host__ __device__ __forceinline__ void stage_rc(int b, int& R, int& C) { const int st = b / 1024, sb = b % 1024, swz = sb ^ (((sb >> 9) & 1) << 5); R = (st >> 1) * 16 + swz / 64; C = (st & 1) * 32 + (swz % 64) / 2; }
__host__ __device__ __forceinline__ int perm32(int rho) { const int n = rho >> 4, i = rho & 15; return 8 * (i >> 2) + 4 * n + (i & 3); }

struct Unit { int pm, pn; };
struct Gemm { const bf16_t* A; const bf16_t* Bt; int lda, ldb, K, a_pn_off; };

struct StaticOrder {
    int nM, nN, nwg, G, c;
    __device__ void init(int M, int N, int G_, int c_) { nM = M / BM; nN = N / BM; nwg = nM * nN; G = G_; c = c_; }
    __device__ bool next(int i, Unit& u) const {
        const long L = (long)i * G + c; if (L >= nwg) return false;
        int wgid = (int)L; { const int q = nwg / NXCD, r = nwg % NXCD, xcd = wgid % NXCD, off = wgid / NXCD; wgid = (xcd < r ? xcd * (q + 1) : r * (q + 1) + (xcd - r) * q) + off; }
        const int nig = WGM * nN, gid = wgid / nig, fm = gid * WGM, gsz = (nM - fm) < WGM ? (nM - fm) : WGM;
        u.pm = fm + ((wgid % nig) % gsz); u.pn = (wgid % nig) / gsz; return true;
    }
};

template <class Epi>
__device__ __forceinline__ void gemm_phase(LAS unsigned char* lds, const Gemm g, const StaticOrder& S, const Epi& E) {
    const int tid = fresh_tid(), wid = __builtin_amdgcn_readfirstlane(tid >> 6), lane = tid & 63, wr = wid >> 2, wc = wid & 3, fr = lane & 15, fq = lane >> 4;
    const int K = g.K, nt = K / BK;
    unsigned voffA[2], voffB[2];
#pragma unroll
    for (int i = 0; i < 2; ++i) { int R, C; stage_rc(tid * 16 + i * 8192, R, C); const int Rb = (R & ~31) + perm32(R & 31);
        voffA[i] = (unsigned)(R * g.lda + C) * 2u; voffB[i] = (unsigned)(Rb * g.ldb + C) * 2u; }
    const size_t kstep = (size_t)(BK * 2);
    const size_t hstepA = (size_t)HALF * g.lda * 2, hstepB = (size_t)HALF * g.ldb * 2;
    const size_t tstepA = 2 * hstepA, tstepB = 2 * hstepB;
    const unsigned ldsw = (unsigned)wid * 1024u;
    const int aoff = lds_byte(wr * 64 + fr, fq * 8), boff = lds_byte(wc * 32 + fr, fq * 8);
#define PG8_SA(b, h) (((b) * 2 + (h)) * HTB)
#define PG8_SB(b, h) ((4 + (b) * 2 + (h)) * HTB)
#define PG8_STAGE(bufoff, gbase, voff) do { const char* _gb = (const char*)(gbase); asm volatile("" : "+s"(_gb)); _Pragma("unroll") for (int _i = 0; _i < 2; ++_i) \
        __builtin_amdgcn_global_load_lds((const unsigned*)(_gb + (voff)[_i]), (LAS unsigned*)(lds + (bufoff) + ldsw + _i * 8192), 16, 0, 0); } while (0)
#define PG8_LDA(dst, b, h) do { _Pragma("unroll") for (int m = 0; m < 4; ++m) _Pragma("unroll") for (int k = 0; k < 2; ++k) dst[m][k] = *(const LAS bf16x8*)(lds + PG8_SA(b, h) + aoff + m * 2048 + k * 1024); } while (0)
#define PG8_LDB(dst, b, h) do { _Pragma("unroll") for (int n = 0; n < 2; ++n) _Pragma("unroll") for (int k = 0; k < 2; ++k) dst[n][k] = *(const LAS bf16x8*)(lds + PG8_SB(b, h) + boff + n * 2048 + k * 1024); } while (0)
#define PG8_MMA(ai, bj, At, Bt) do { __builtin_amdgcn_s_setprio(1); _Pragma("unroll") for (int m = 0; m < 4; ++m) _Pragma("unroll") for (int n = 0; n < 2; ++n) _Pragma("unroll") for (int k = 0; k < 2; ++k) \
        acc[ai][bj][m][n] = __builtin_amdgcn_mfma_f32_16x16x32_bf16(Bt[n][k], At[m][k], acc[ai][bj][m][n], 0, 0, 0); __builtin_amdgcn_s_setprio(0); } while (0)
#define PG8_WAIT_V(n) asm volatile("s_waitcnt vmcnt(" #n ")" ::: "memory")
#define PG8_WAIT_L(n) asm volatile("s_waitcnt lgkmcnt(" #n ")" ::: "memory")
#define PG8_BAR __builtin_amdgcn_s_barrier()
#define PG8_SCHED __builtin_amdgcn_sched_barrier(0)
    Unit cur, nxt; int ui = 0;
    if (!S.next(0, cur)) return;
    f32x4 acc[2][2][4][2];
#pragma unroll
    for (int a = 0; a < 2; ++a)
#pragma unroll
        for (int b = 0; b < 2; ++b)
#pragma unroll
            for (int m = 0; m < 4; ++m)
#pragma unroll
                for (int n = 0; n < 2; ++n) acc[a][b][m][n] = (f32x4){0.f, 0.f, 0.f, 0.f};
    bf16x8 At[4][2], B0[2][2], B1[2][2];
    const char* cA = (const char*)g.A + (size_t)cur.pm * tstepA + (size_t)cur.pn * g.a_pn_off * 2; const char* cB = (const char*)g.Bt + (size_t)cur.pn * tstepB;
    PG8_STAGE(PG8_SB(0, 0), cB, voffB); PG8_STAGE(PG8_SA(0, 0), cA, voffA); PG8_STAGE(PG8_SB(0, 1), cB + hstepB, voffB); PG8_STAGE(PG8_SA(0, 1), cA + hstepA, voffA);
    if (wr == 1) PG8_BAR;
    PG8_WAIT_V(4); PG8_BAR;
    PG8_STAGE(PG8_SB(1, 0), cB + kstep, voffB); PG8_STAGE(PG8_SA(1, 0), cA + kstep, voffA); PG8_STAGE(PG8_SB(1, 1), cB + hstepB + kstep, voffB);
    PG8_WAIT_V(6); PG8_BAR;
    for (;;) {
        const bool has_next = S.next(ui + 1, nxt);
        const char* nA = has_next ? (const char*)g.A + (size_t)nxt.pm * tstepA + (size_t)nxt.pn * g.a_pn_off * 2 : cA; const char* nB = has_next ? (const char*)g.Bt + (size_t)nxt.pn * tstepB : cB;
        for (int t = 0; t < nt; t += 2) {
            const bool last = (t == nt - 2);
            const char* a1 = cA + (size_t)(t + 1) * kstep;
            const char* a2 = last ? nA : cA + (size_t)(t + 2) * kstep; const char* b2 = last ? nB : cB + (size_t)(t + 2) * kstep;
            const char* a3 = a2 + kstep; const char* b3 = b2 + kstep;
            PG8_LDB(B0, 0, 0); PG8_SCHED; PG8_LDA(At, 0, 0); PG8_STAGE(PG8_SA(1, 1), a1 + hstepA, voffA);
            PG8_WAIT_L(8); PG8_BAR; PG8_WAIT_L(0); PG8_MMA(0, 0, At, B0); PG8_BAR; PG8_SCHED;
            PG8_LDB(B1, 0, 1); PG8_STAGE(PG8_SB(0, 0), b2, voffB);
            PG8_BAR; PG8_WAIT_L(0); PG8_MMA(0, 1, At, B1); PG8_BAR;
            PG8_LDA(At, 0, 1); PG8_STAGE(PG8_SA(0, 0), a2, voffA);
            PG8_BAR; PG8_WAIT_L(0); PG8_MMA(1, 0, At, B0); PG8_BAR; PG8_SCHED;
            PG8_STAGE(PG8_SB(0, 1), b2 + hstepB, voffB);
            PG8_WAIT_V(6); PG8_BAR; PG8_MMA(1, 1, At, B1); PG8_BAR;
            PG8_LDB(B0, 1, 0); PG8_SCHED; PG8_LDA(At, 1, 0); PG8_STAGE(PG8_SA(0, 1), a2 + hstepA, voffA);
            PG8_WAIT_L(8); PG8_BAR; PG8_WAIT_L(0); PG8_MMA(0, 0, At, B0); PG8_BAR; PG8_SCHED;
            PG8_LDB(B1, 1, 1); PG8_STAGE(PG8_SB(1, 0), b3, voffB);
            PG8_BAR; PG8_WAIT_L(0); PG8_MMA(0, 1, At, B1); PG8_BAR;
            PG8_LDA(At, 1, 1); PG8_STAGE(PG8_SA(1, 0), a3, voffA);
            PG8_BAR; PG8_WAIT_L(0); PG8_MMA(1, 0, At, B0); PG8_BAR; PG8_SCHED;
            PG8_STAGE(PG8_SB(1, 1), b3 + hstepB, voffB);
            PG8_WAIT_V(6); PG8_BAR; PG8_MMA(1, 1, At, B1); PG8_BAR;
        }
        E(acc, cur, wr, wc, fr, fq);
        if (!has_next) break;
#pragma unroll
        for (int a = 0; a < 2; ++a)
#pragma unroll
            for (int b = 0; b < 2; ++b)
#pragma unroll
                for (int m = 0; m < 4; ++m)
#pragma unroll
                    for (int n = 0; n < 2; ++n) acc[a][b][m][n] = (f32x4){0.f, 0.f, 0.f, 0.f};
        cur = nxt; cA = nA; cB = nB; ++ui;
    }
    PG8_WAIT_V(0);
    if (wr == 0) PG8_BAR;
    PG8_BAR;
#undef PG8_SA
#undef PG8_SB
#undef PG8_STAGE
#undef PG8_LDA
#undef PG8_LDB
#undef PG8_MMA
#undef PG8_WAIT_V
#undef PG8_WAIT_L
#undef PG8_BAR
#undef PG8_SCHED
}
}
using pg8::Unit;

__device__ __forceinline__ u32x4 pack8(const f32x4 v0, const f32x4 v1) { u32x4 w; w.x = cvt_pk_bf16(v0[0], v0[1]); w.y = cvt_pk_bf16(v0[2], v0[3]); w.z = cvt_pk_bf16(v1[0], v1[1]); w.w = cvt_pk_bf16(v1[2], v1[3]); return w; }

struct EpiProj {
    bf16_t* qkv; bf16_t* poolin; bf16_t* sga; bf16_t* sgb;
    __device__ __forceinline__ void operator()(const f32x4 (&acc)[2][2][4][2], const Unit& u, int wr, int wc, int fr, int fq) const {
        const int pn = u.pn, row0 = u.pm * 256 + wr * 64 + fr, cw = wc * 32 + 8 * fq;
        if (pn < 9) {
            const int which = pn / 3, g = pn - 3 * which, sh = 2 * g; const float sc = which == 0 ? 0.125f : 1.0f;
            bf16_t* base = qkv + (size_t)which * ((size_t)T * 768) + (size_t)g * ((size_t)T * 256);
#pragma unroll
            for (int ai = 0; ai < 2; ++ai)
#pragma unroll
                for (int m = 0; m < 4; ++m) { const int row = row0 + ai * 128 + m * 16, b = row >> 11, s = row & 2047, i = s >> sh, r = s & ((1 << sh) - 1), drow = (b << 11) + r * (2048 >> sh) + i;
                    bf16_t* rowp = base + (size_t)drow * 256 + cw;
#pragma unroll
                    for (int bj = 0; bj < 2; ++bj) *(u32x4*)(rowp + bj * 128) = pack8(acc[ai][bj][m][0] * sc, acc[ai][bj][m][1] * sc); }
        } else if (pn < 13) {
            bf16_t* base = poolin + (pn - 9) * 256 + cw;
#pragma unroll
            for (int ai = 0; ai < 2; ++ai)
#pragma unroll
                for (int m = 0; m < 4; ++m) { bf16_t* rowp = base + (size_t)(row0 + ai * 128 + m * 16) * DM;
#pragma unroll
                    for (int bj = 0; bj < 2; ++bj) *(u32x4*)(rowp + bj * 128) = pack8(acc[ai][bj][m][0], acc[ai][bj][m][1]); }
        } else {
            bf16_t* base = (pn < 17 ? sga : sgb) + ((pn - 13) & 3) * 256 + cw;
#pragma unroll
            for (int ai = 0; ai < 2; ++ai)
#pragma unroll
                for (int m = 0; m < 4; ++m) { bf16_t* rowp = base + (size_t)(row0 + ai * 128 + m * 16) * DM;
#pragma unroll
                    for (int bj = 0; bj < 2; ++bj) { f32x4 v0 = acc[ai][bj][m][0], v1 = acc[ai][bj][m][1];
#pragma unroll
                        for (int j = 0; j < 4; ++j) { v0[j] = fast_sigmoid(v0[j]); v1[j] = fast_sigmoid(v1[j]); }
                        *(u32x4*)(rowp + bj * 128) = pack8(v0, v1); } }
        }
    }
};
struct EpiPg {
    bf16_t* out; const float* scale;
    __device__ __forceinline__ void operator()(const f32x4 (&acc)[2][2][4][2], const Unit& u, int wr, int wc, int fr, int fq) const {
        const int row0 = u.pm * 256 + wr * 64 + fr, col0 = u.pn * 256 + wc * 32 + 8 * fq;
        f32x4 sv[2][2];
#pragma unroll
        for (int bj = 0; bj < 2; ++bj) { sv[bj][0] = *(const f32x4*)(scale + col0 + bj * 128); sv[bj][1] = *(const f32x4*)(scale + col0 + bj * 128 + 4); }
#pragma unroll
        for (int ai = 0; ai < 2; ++ai)
#pragma unroll
            for (int m = 0; m < 4; ++m) { bf16_t* rowp = out + (size_t)(row0 + ai * 128 + m * 16) * DM + col0;
#pragma unroll
                for (int bj = 0; bj < 2; ++bj) *(u32x4*)(rowp + bj * 128) = pack8(acc[ai][bj][m][0] * sv[bj][0], acc[ai][bj][m][1] * sv[bj][1]); }
    }
};
__device__ __forceinline__ void unpack8(const u32x4 w, f32x4& a, f32x4& b) {
    a[0] = __uint_as_float(w.x << 16); a[1] = __uint_as_float(w.x & 0xffff0000u); a[2] = __uint_as_float(w.y << 16); a[3] = __uint_as_float(w.y & 0xffff0000u);
    b[0] = __uint_as_float(w.z << 16); b[1] = __uint_as_float(w.z & 0xffff0000u); b[2] = __uint_as_float(w.w << 16); b[3] = __uint_as_float(w.w & 0xffff0000u);
}
struct EpiBrA {
    float* tmp; const bf16_t* sg;
    __device__ __forceinline__ void operator()(const f32x4 (&acc)[2][2][4][2], const Unit& u, int wr, int wc, int fr, int fq) const {
        const int row0 = u.pm * 256 + wr * 64 + fr, col0 = u.pn * 256 + wc * 32 + 8 * fq;
#pragma unroll
        for (int ai = 0; ai < 2; ++ai)
#pragma unroll
            for (int m = 0; m < 4; ++m) { const size_t off = (size_t)(row0 + ai * 128 + m * 16) * DM + col0;
#pragma unroll
                for (int bj = 0; bj < 2; ++bj) { f32x4 g0, g1; unpack8(*(const u32x4*)(sg + off + bj * 128), g0, g1);
                    *(f32x4*)(tmp + off + bj * 128) = acc[ai][bj][m][0] * g0; *(f32x4*)(tmp + off + bj * 128 + 4) = acc[ai][bj][m][1] * g1; }
                asm volatile("" ::: "memory"); }
    }
};
struct EpiBrB {
    bf16_t* merged; const float* tmp; const bf16_t* sg;
    __device__ __forceinline__ void operator()(const f32x4 (&acc)[2][2][4][2], const Unit& u, int wr, int wc, int fr, int fq) const {
        const int row0 = u.pm * 256 + wr * 64 + fr, col0 = u.pn * 256 + wc * 32 + 8 * fq;
#pragma unroll
        for (int ai = 0; ai < 2; ++ai)
#pragma unroll
            for (int m = 0; m < 4; ++m) { const size_t off = (size_t)(row0 + ai * 128 + m * 16) * DM + col0;
#pragma unroll
                for (int bj = 0; bj < 2; ++bj) { f32x4 g0, g1; unpack8(*(const u32x4*)(sg + off + bj * 128), g0, g1);
                    const f32x4 t0 = *(const f32x4*)(tmp + off + bj * 128), t1 = *(const f32x4*)(tmp + off + bj * 128 + 4);
                    *(u32x4*)(merged + off + bj * 128) = pack8(t0 + acc[ai][bj][m][0] * g0, t1 + acc[ai][bj][m][1] * g1); }
                asm volatile("" ::: "memory"); }
    }
};
struct EpiRes {
    float* out; const float* res; const float* modv; int gate_off;
    __device__ __forceinline__ void operator()(const f32x4 (&acc)[2][2][4][2], const Unit& u, int wr, int wc, int fr, int fq) const {
        const int row0 = u.pm * 256 + wr * 64 + fr, col0 = u.pn * 256 + wc * 32 + 8 * fq;
        const float* gp = modv + (size_t)(u.pm >> 3) * NMOD + gate_off + col0;
        f32x4 gv[2][2];
#pragma unroll
        for (int bj = 0; bj < 2; ++bj) { gv[bj][0] = *(const f32x4*)(gp + bj * 128); gv[bj][1] = *(const f32x4*)(gp + bj * 128 + 4); }
#pragma unroll
        for (int ai = 0; ai < 2; ++ai)
#pragma unroll
            for (int m = 0; m < 4; ++m) { const size_t off = (size_t)(row0 + ai * 128 + m * 16) * DM + col0;
#pragma unroll
                for (int bj = 0; bj < 2; ++bj) { const f32x4 r0 = *(const f32x4*)(res + off + bj * 128), r1 = *(const f32x4*)(res + off + bj * 128 + 4);
                    *(f32x4*)(out + off + bj * 128) = r0 * ALPHA + acc[ai][bj][m][0] * gv[bj][0]; *(f32x4*)(out + off + bj * 128 + 4) = r1 * ALPHA + acc[ai][bj][m][1] * gv[bj][1]; }
                asm volatile("" ::: "memory"); }
    }
};
struct EpiGu {
    bf16_t* act;
    __device__ __forceinline__ void operator()(const f32x4 (&acc)[2][2][4][2], const Unit& u, int wr, int wc, int fr, int fq) const {
        const int row0 = u.pm * 256 + wr * 64 + fr, col0 = u.pn * 128 + wc * 32 + 8 * fq;
#pragma unroll
        for (int ai = 0; ai < 2; ++ai)
#pragma unroll
            for (int m = 0; m < 4; ++m) { f32x4 v0, v1;
#pragma unroll
                for (int j = 0; j < 4; ++j) { const float g0 = acc[ai][0][m][0][j], g1 = acc[ai][0][m][1][j];
                    v0[j] = g0 * fast_sigmoid(g0) * acc[ai][1][m][0][j]; v1[j] = g1 * fast_sigmoid(g1) * acc[ai][1][m][1][j]; }
                *(u32x4*)(act + (size_t)(row0 + ai * 128 + m * 16) * DFF + col0) = pack8(v0, v1); }
    }
};

constexpr int QS_OFF = 0, KS_OFF = 128 * 144, VS_OFF = KS_OFF + 256 * 144, ATT_ROWB = 144;
__device__ __forceinline__ void attn_unit(LAS unsigned char* lds, const bf16_t* QKV, bf16_t* ATTO, float* LSE, int unit, int tid, int wave, int lane) {
    const int rn = unit & 15, hs = (unit >> 4) & 3, bg = unit >> 6, g = bg % 3, b = bg / 3;
    const int sh = 2 * g, L = 2048 >> sh, nbs = 4 - sh;
    const int r = rn >> nbs, n = rn & ((1 << nbs) - 1);
    const size_t gbase = (size_t)g * ((size_t)T * 256);
    const int rowbase = b * 2048 + r * L;
    const bf16_t* Qg = QKV + gbase + (size_t)(rowbase + n * 128) * 256 + hs * 64;
    const bf16_t* Kg = QKV + (size_t)T * 768 + gbase + (size_t)rowbase * 256 + hs * 64;
    const bf16_t* Vg = QKV + 2 * (size_t)T * 768 + gbase + (size_t)rowbase * 256 + hs * 64;
    u32x4 rq[2], rk[4], rv[4];
#pragma unroll
    for (int i = 0; i < 2; ++i) { const int c = tid + 512 * i, row = c >> 3, part = c & 7; rq[i] = *(const u32x4*)(Qg + (size_t)row * 256 + part * 8); }
#pragma unroll
    for (int i = 0; i < 4; ++i) { const int c = tid + 512 * i, j = c >> 3, part = c & 7; int ik = n * 128 - 128 + j; if (ik < 0) ik += 128;
        rk[i] = *(const u32x4*)(Kg + (size_t)ik * 256 + part * 8); rv[i] = *(const u32x4*)(Vg + (size_t)ik * 256 + part * 8); }
    __syncthreads();
#pragma unroll
    for (int i = 0; i < 2; ++i) { const int c = tid + 512 * i, row = c >> 3, part = c & 7; *(LAS u32x4*)(lds + QS_OFF + row * ATT_ROWB + part * 16) = rq[i]; }
#pragma unroll
    for (int i = 0; i < 4; ++i) { const int c = tid + 512 * i, j = c >> 3, part = c & 7;
        *(LAS u32x4*)(lds + KS_OFF + j * ATT_ROWB + part * 16) = rk[i]; *(LAS u32x4*)(lds + VS_OFF + j * ATT_ROWB + part * 16) = rv[i]; }
    __syncthreads();
    const int fr = lane & 15, fq = lane >> 4;
    const int qrow = 16 * wave + fr, ks = (wave == 7) ? 96 : 16 * wave;
    bf16x8 qf[2];
#pragma unroll
    for (int k = 0; k < 2; ++k) qf[k] = *(const LAS bf16x8*)(lds + QS_OFF + qrow * ATT_ROWB + (32 * k + fq * 8) * 2);
    f32x4 sc[10];
#pragma unroll
    for (int kt = 0; kt < 10; ++kt) { f32x4 a = (f32x4){0.f, 0.f, 0.f, 0.f};
#pragma unroll
        for (int k = 0; k < 2; ++k) { const bf16x8 kf = *(const LAS bf16x8*)(lds + KS_OFF + (ks + 16 * kt + fr) * ATT_ROWB + (32 * k + fq * 8) * 2);
            a = __builtin_amdgcn_mfma_f32_16x16x32_bf16(kf, qf[k], a, 0, 0, 0); }
        sc[kt] = a; }
    const int hidx = g * 4 + hs;
    const float slope = hidx < 8 ? exp2f(-0.5f * (float)(hidx + 1)) : exp2f(-(float)(hidx - 3));
    const float LOG2E = 1.4426950408889634f;
    const float sl2 = slope * (float)(1 << sh) * LOG2E;
    float mx = -INFINITY;
#pragma unroll
    for (int kt = 0; kt < 10; ++kt)
#pragma unroll
        for (int j = 0; j < 4; ++j) { const int kj = ks + 16 * kt + 4 * fq + j, diff = 128 + qrow - kj;
            const bool valid = (diff >= 0) && (diff <= 128) && (n > 0 || kj >= 128);
            const float v = valid ? sc[kt][j] * LOG2E - sl2 * (float)diff : -INFINITY; sc[kt][j] = v; mx = fmaxf(mx, v); }
    mx = fmaxf(mx, __shfl_xor(mx, 16)); mx = fmaxf(mx, __shfl_xor(mx, 32));
    float l = 0.f;
#pragma unroll
    for (int kt = 0; kt < 10; ++kt)
#pragma unroll
        for (int j = 0; j < 4; ++j) { const float p = exp2f(sc[kt][j] - mx); sc[kt][j] = p; l += p; }
    l += __shfl_xor(l, 16); l += __shfl_xor(l, 32);
    bf16x8 pf[5];
#pragma unroll
    for (int pp = 0; pp < 5; ++pp) { const u32x4 w = pack8(sc[2 * pp], sc[2 * pp + 1]); pf[pp] = __builtin_bit_cast(bf16x8, w); }
    const float rl = 1.0f / l;
    const int q4 = fr >> 2, p4 = fr & 3;
    const int t = b * 2048 + ((n * 128 + qrow) << sh) + r;
    bf16_t* orow = ATTO + gbase + (size_t)t * 256 + hs * 64 + 4 * fq;
#pragma unroll
    for (int dt = 0; dt < 4; ++dt) { f32x4 o = (f32x4){0.f, 0.f, 0.f, 0.f};
#pragma unroll
        for (int pp = 0; pp < 5; ++pp) {
            const s16x4 lo = __builtin_amdgcn_ds_read_tr16_b64_v4i16((LAS s16x4*)(lds + VS_OFF + (ks + 32 * pp + 4 * fq + q4) * ATT_ROWB + (16 * dt + 4 * p4) * 2));
            const s16x4 hi = __builtin_amdgcn_ds_read_tr16_b64_v4i16((LAS s16x4*)(lds + VS_OFF + (ks + 32 * pp + 16 + 4 * fq + q4) * ATT_ROWB + (16 * dt + 4 * p4) * 2));
            const bf16x8 vf = __builtin_shufflevector(lo, hi, 0, 1, 2, 3, 4, 5, 6, 7);
            o = __builtin_amdgcn_mfma_f32_16x16x32_bf16(vf, pf[pp], o, 0, 0, 0); }
        u32x2 w; w.x = cvt_pk_bf16(o[0] * rl, o[1] * rl); w.y = cvt_pk_bf16(o[2] * rl, o[3] * rl);
        *(u32x2*)(orow + 16 * dt) = w; }
    if (fq == 0) LSE[((size_t)g * T + t) * 4 + hs] = (mx + log2f(l)) * 0.6931471805599453f;
}

template <int W>
__device__ __forceinline__ void pool_item(const bf16_t* POOLIN, bf16_t* PM, int pair, int g, int lane) {
    const int tok = pair * 2 + (lane >> 5), s = tok & 2047, col = g * 256 + (lane & 31) * 8;
    const bf16_t* p = POOLIN + (size_t)tok * DM + col;
    u32x4 v[W];
#pragma unroll
    for (int i = 0; i < W; ++i) { const int back = (i <= s) ? i : 0; v[i] = *(const u32x4*)(p - (size_t)back * DM); }
    f32x4 s0 = (f32x4){0.f, 0.f, 0.f, 0.f}, s1 = s0, u0, u1;
#pragma unroll
    for (int i = 0; i < W; ++i) { f32x4 a, bb; unpack8(v[i], a, bb); if (i == 0) { u0 = a; u1 = bb; } if (i <= s) { s0 += a; s1 += bb; } }
    const float rc = 1.0f / (float)((s + 1) < W ? (s + 1) : W);
    *(u32x4*)(PM + (size_t)tok * DM + col) = pack8(s0 * rc - u0, s1 * rc - u1);
}

struct Args {
    const float* x; const float* c; const float* w_ada; const float* b_ada; const float* w_in; const float* w_branch_att; const float* w_pool_group; const float* pool_scale;
    const float* w_branch_pool; const float* w_out; const float* ln1_g; const float* ln1_b; const float* w_gate; const float* w_up; const float* w_down; const float* ln2_g; const float* ln2_b;
    float* out; unsigned char* ws;
};

#define CAS __attribute__((address_space(4)))
typedef const CAS Args* ArgsP;
__device__ __forceinline__ ArgsP fresh_args() { unsigned long long p = (unsigned long long)__builtin_amdgcn_kernarg_segment_ptr(); asm volatile("" : "+s"(p)); return (ArgsP)p; }

__device__ __forceinline__ void transpose_item(const float* W, int N, int k0, int n0, bf16_t* WT, int ldt, int drow0, LAS float* scr, int lane) {
#pragma unroll 8
    for (int i = 0; i < 32; ++i) { const int kk = 2 * i + (lane >> 5); scr[kk * 33 + (lane & 31)] = W[(size_t)(k0 + kk) * N + n0 + (lane & 31)]; }
    asm volatile("s_waitcnt lgkmcnt(0)" ::: "memory");
    const int c = lane & 7;
#pragma unroll
    for (int j = 0; j < 4; ++j) { const int n = (lane >> 3) + 8 * j; const LAS float* s = scr + (8 * c) * 33 + n;
        u32x4 o; o.x = cvt_pk_bf16(s[0 * 33], s[1 * 33]); o.y = cvt_pk_bf16(s[2 * 33], s[3 * 33]); o.z = cvt_pk_bf16(s[4 * 33], s[5 * 33]); o.w = cvt_pk_bf16(s[6 * 33], s[7 * 33]);
        *(u32x4*)(WT + (size_t)(drow0 + n) * ldt + k0 + 8 * c) = o; }
    asm volatile("s_waitcnt lgkmcnt(0)" ::: "memory");
}

__global__ void __launch_bounds__(NTHR, 2) fwd_megakernel(Args a) {
    extern __shared__ __attribute__((aligned(16))) unsigned char lds_raw[];
    cg::grid_group grid = cg::this_grid();
    LAS unsigned char* lds = (LAS unsigned char*)lds_raw;
    const int G = gridDim.x, NGW = G * NWAVES;
#define FRESH_IDS() const int tid = fresh_tid(), lane = tid & 63, wave = __builtin_amdgcn_readfirstlane(tid >> 6), gw = blockIdx.x * NWAVES + wave; (void)lane; (void)gw
#define PTRS() ArgsP ap = fresh_args(); unsigned char* ws = ap->ws; (void)ws
#define Win_t ((bf16_t*)(ws + WS_WIN))
#define Wa_t ((bf16_t*)(ws + WS_WA))
#define Wpg_t ((bf16_t*)(ws + WS_WPG))
#define Wbp_t ((bf16_t*)(ws + WS_WBP))
#define Wo_t ((bf16_t*)(ws + WS_WO))
#define Wgu_t ((bf16_t*)(ws + WS_WGU))
#define Wd_t ((bf16_t*)(ws + WS_WD))
#define MOD ((float*)(ws + WS_MOD))
#define LSE ((float*)(ws + WS_LSE))
#define H ((bf16_t*)(ws + WS_B))
#define PM H
#define MERGED H
#define H2 H
#define QKV ((bf16_t*)(ws + WS_C))
#define TMP ((float*)(ws + WS_C))
#define X1 ((float*)(ws + WS_C))
#define POOLIN ((bf16_t*)(ws + WS_D))
#define PG POOLIN
#define ACT POOLIN
#define SGA ((bf16_t*)(ws + WS_E))
#define SGB (SGA + (size_t)T * DM)
#define Y ((float*)(ws + WS_E))
#define ATTO ((bf16_t*)(ws + WS_F))
#define ATT ((bf16_t*)(ws + WS_G))

    if (blockIdx.x < 192) {
        FRESH_IDS(); PTRS();
        LAS float* sl = (LAS float*)lds;
        LAS float* red = (LAS float*)(lds + 65536);
        for (int idx = tid; idx < NB * DM; idx += NTHR) { const int b = idx >> 10, k = idx & 1023; const float v = ap->c[idx]; sl[k * 16 + b] = v / (1.0f + __expf(-v)); }
        __syncthreads();
        const int n0 = blockIdx.x * 32, col = lane & 31, kh = lane >> 5;
        float accm[16];
#pragma unroll
        for (int b = 0; b < 16; ++b) accm[b] = 0.f;
        const float* wp = ap->w_ada + (size_t)(wave * 128 + kh) * NMOD + n0 + col;
#pragma unroll 8
        for (int j = 0; j < 64; ++j) { const float w = wp[(size_t)(2 * j) * NMOD]; const int k = wave * 128 + 2 * j + kh;
            const LAS f32x4* s4 = (const LAS f32x4*)(sl + k * 16);
#pragma unroll
            for (int q = 0; q < 4; ++q) { const f32x4 sv = s4[q];
#pragma unroll
                for (int e = 0; e < 4; ++e) accm[q * 4 + e] += sv[e] * w; } }
#pragma unroll
        for (int b = 0; b < 16; ++b) { accm[b] += __shfl_xor(accm[b], 32); }
        if (kh == 0) {
#pragma unroll
            for (int b = 0; b < 16; ++b) red[(wave * 16 + b) * 32 + col] = accm[b]; }
        __syncthreads();
        { const int b = tid >> 5, cc = tid & 31; float v = ap->b_ada[n0 + cc];
#pragma unroll
          for (int w = 0; w < 8; ++w) v += red[(w * 16 + b) * 32 + cc];
          MOD[(size_t)b * NMOD + n0 + cc] = v; }
        __syncthreads();
    }
    {
        FRESH_IDS(); PTRS();
        LAS float* scr = (LAS float*)(lds + wave * 16384);
        for (int it = gw; it < 8192; it += NGW) {
            int r = it;
            if (r < 2688) { const int kb = r / 168, nb = r % 168; transpose_item(ap->w_in, INW, kb * 64, nb * 32, Win_t, DM, nb * 32, scr, lane); continue; } r -= 2688;
            if (r < 128) { const int kb = r / 32, nb = r % 32; transpose_item(ap->w_branch_att, DM, kb * 64, nb * 32, Wa_t, 256, nb * 32, scr, lane); continue; } r -= 128;
            if (r < 128) { const int gg = r >> 5, q = r & 31, kb = q / 8, nb = q % 8; transpose_item(ap->w_pool_group + gg * 65536, 256, kb * 64, nb * 32, Wpg_t + gg * 65536, 256, nb * 32, scr, lane); continue; } r -= 128;
            if (r < 512) { const int kb = r / 32, nb = r % 32; transpose_item(ap->w_branch_pool, DM, kb * 64, nb * 32, Wbp_t, DM, nb * 32, scr, lane); continue; } r -= 512;
            if (r < 512) { const int kb = r / 32, nb = r % 32; transpose_item(ap->w_out, DM, kb * 64, nb * 32, Wo_t, DM, nb * 32, scr, lane); continue; } r -= 512;
            if (r < 1408) { const int kb = r / 88, nb = r % 88, n0 = nb * 32; transpose_item(ap->w_gate, DFF, kb * 64, n0, Wgu_t, DM, (n0 >> 7) * 256 + (n0 & 127), scr, lane); continue; } r -= 1408;
            if (r < 1408) { const int kb = r / 88, nb = r % 88, n0 = nb * 32; transpose_item(ap->w_up, DFF, kb * 64, n0, Wgu_t, DM, (n0 >> 7) * 256 + 128 + (n0 & 127), scr, lane); continue; } r -= 1408;
            { const int kb = r / 32, nb = r % 32; transpose_item(ap->w_down, DM, kb * 64, nb * 32, Wd_t, DFF, nb * 32, scr, lane); }
        }
    }
    grid.sync();

    { FRESH_IDS(); PTRS();
    for (int m = gw; m < T; m += NGW) {
        const float* mr = MOD + (size_t)(m >> 11) * NMOD;
        const f32x4* xr = (const f32x4*)(ap->x + (size_t)m * DM) + lane;
        unsigned long long* o8 = (unsigned long long*)(H + (size_t)m * DM) + lane;
#pragma unroll
        for (int j = 0; j < 4; ++j) { const f32x4 v = xr[64 * j]; const f32x4 sh = *((const f32x4*)(mr) + lane + 64 * j), sc = *((const f32x4*)(mr + 1024) + lane + 64 * j);
            const f32x4 h = v * (sc + 1.0f) + sh;
            o8[64 * j] = (unsigned long long)cvt_pk_bf16(h[0], h[1]) | ((unsigned long long)cvt_pk_bf16(h[2], h[3]) << 32); }
    } }
    grid.sync();

    { PTRS(); pg8::Gemm g{H, Win_t, DM, DM, DM, 0}; pg8::StaticOrder S; S.init(T, INW, G, (int)blockIdx.x);
      EpiProj E{QKV, POOLIN, SGA, SGB}; pg8::gemm_phase(lds, g, S, E); }
    grid.sync();

    { FRESH_IDS(); PTRS();
    for (int u = blockIdx.x; u < 3072; u += G) attn_unit(lds, QKV, ATTO, LSE, u, tid, wave, lane); }
    { FRESH_IDS(); PTRS();
    for (int k = 0; k < 32; ++k) {
        const int gsel = (k + gw) & 3, pair = gw + NGW * (k >> 2);
        if (pair < T / 2) {
            if (gsel == 0) pool_item<2>(POOLIN, PM, pair, 0, lane); else if (gsel == 1) pool_item<4>(POOLIN, PM, pair, 1, lane);
            else if (gsel == 2) pool_item<8>(POOLIN, PM, pair, 2, lane); else pool_item<16>(POOLIN, PM, pair, 3, lane);
        }
    } }
    __syncthreads();
    grid.sync();

    { PTRS(); pg8::Gemm g{PM, Wpg_t, DM, 256, 256, 256}; pg8::StaticOrder S; S.init(T, DM, G, (int)blockIdx.x);
      EpiPg E{PG, ap->pool_scale}; pg8::gemm_phase(lds, g, S, E); }
    { FRESH_IDS(); PTRS();
    for (int m = gw; m < T; m += NGW) {
        const int hs = lane >> 4;
        const float l0 = LSE[((size_t)0 * T + m) * 4 + hs], l1 = LSE[((size_t)1 * T + m) * 4 + hs], l2 = LSE[((size_t)2 * T + m) * 4 + hs];
        const float mxl = fmaxf(l0, fmaxf(l1, l2));
        const float e0 = __expf(l0 - mxl), e1 = __expf(l1 - mxl), e2 = __expf(l2 - mxl), rs = 1.0f / (e0 + e1 + e2);
        const float w0 = e0 * rs, w1 = e1 * rs, w2 = e2 * rs;
        const u32x2 a0 = *((const u32x2*)(ATTO + (size_t)m * 256) + lane), a1 = *((const u32x2*)(ATTO + (size_t)T * 256 + (size_t)m * 256) + lane), a2 = *((const u32x2*)(ATTO + 2 * (size_t)T * 256 + (size_t)m * 256) + lane);
        float o[4];
        o[0] = w0 * __uint_as_float(a0.x << 16) + w1 * __uint_as_float(a1.x << 16) + w2 * __uint_as_float(a2.x << 16);
        o[1] = w0 * __uint_as_float(a0.x & 0xffff0000u) + w1 * __uint_as_float(a1.x & 0xffff0000u) + w2 * __uint_as_float(a2.x & 0xffff0000u);
        o[2] = w0 * __uint_as_float(a0.y << 16) + w1 * __uint_as_float(a1.y << 16) + w2 * __uint_as_float(a2.y << 16);
        o[3] = w0 * __uint_as_float(a0.y & 0xffff0000u) + w1 * __uint_as_float(a1.y & 0xffff0000u) + w2 * __uint_as_float(a2.y & 0xffff0000u);
        u32x2 w; w.x = cvt_pk_bf16(o[0], o[1]); w.y = cvt_pk_bf16(o[2], o[3]);
        *((u32x2*)(ATT + (size_t)m * 256) + lane) = w;
    } }
    grid.sync();

    { PTRS(); pg8::Gemm g{ATT, Wa_t, 256, 256, 256, 0}; pg8::StaticOrder S; S.init(T, DM, G, (int)blockIdx.x);
      EpiBrA E{TMP, SGA}; pg8::gemm_phase(lds, g, S, E); }
    { PTRS(); pg8::Gemm g{PG, Wbp_t, DM, DM, DM, 0}; pg8::StaticOrder S; S.init(T, DM, G, (int)blockIdx.x);
      EpiBrB E{MERGED, TMP, SGB}; pg8::gemm_phase(lds, g, S, E); }
    grid.sync();

    { PTRS(); pg8::Gemm g{MERGED, Wo_t, DM, DM, DM, 0}; pg8::StaticOrder S; S.init(T, DM, G, (int)blockIdx.x);
      EpiRes E{Y, ap->x, MOD, 2048}; pg8::gemm_phase(lds, g, S, E); }
    grid.sync();

    { FRESH_IDS(); PTRS();
    for (int m = gw; m < T; m += NGW) {
        const float* mr = MOD + (size_t)(m >> 11) * NMOD;
        const f32x4* yr = (const f32x4*)(Y + (size_t)m * DM) + lane;
        f32x4 v[4]; float s = 0.f;
#pragma unroll
        for (int j = 0; j < 4; ++j) { v[j] = yr[64 * j]; s += (v[j][0] + v[j][1]) + (v[j][2] + v[j][3]); }
        const float mean = wave_sum(s) * (1.f / DM); float s2 = 0.f;
#pragma unroll
        for (int j = 0; j < 4; ++j) { v[j] = v[j] - mean; s2 += (v[j][0] * v[j][0] + v[j][1] * v[j][1]) + (v[j][2] * v[j][2] + v[j][3] * v[j][3]); }
        const float rstd = 1.f / sqrtf(wave_sum(s2) * (1.f / DM) + LN_EPS);
        f32x4* xo = (f32x4*)(X1 + (size_t)m * DM) + lane;
        unsigned long long* o8 = (unsigned long long*)(H2 + (size_t)m * DM) + lane;
#pragma unroll
        for (int j = 0; j < 4; ++j) { const f32x4 gg = *((const f32x4*)ap->ln1_g + lane + 64 * j), bb = *((const f32x4*)ap->ln1_b + lane + 64 * j);
            const f32x4 x1 = v[j] * rstd * gg + bb; xo[64 * j] = x1;
            const f32x4 sh = *((const f32x4*)(mr + 3072) + lane + 64 * j), sc = *((const f32x4*)(mr + 4096) + lane + 64 * j);
            const f32x4 h = x1 * (sc + 1.0f) + sh;
            o8[64 * j] = (unsigned long long)cvt_pk_bf16(h[0], h[1]) | ((unsigned long long)cvt_pk_bf16(h[2], h[3]) << 32); }
    } }
    grid.sync();

    { PTRS(); pg8::Gemm g{H2, Wgu_t, DM, DM, DM, 0}; pg8::StaticOrder S; S.init(T, 2 * DFF, G, (int)blockIdx.x);
      EpiGu E{ACT}; pg8::gemm_phase(lds, g, S, E); }
    grid.sync();

    { PTRS(); pg8::Gemm g{ACT, Wd_t, DFF, DFF, DFF, 0}; pg8::StaticOrder S; S.init(T, DM, G, (int)blockIdx.x);
      EpiRes E{ap->out, X1, MOD, 5120}; pg8::gemm_phase(lds, g, S, E); }
    grid.sync();

    { FRESH_IDS(); PTRS();
    for (int m = gw; m < T; m += NGW) {
        f32x4* yr = (f32x4*)(ap->out + (size_t)m * DM) + lane;
        f32x4 v[4]; float s = 0.f;
#pragma unroll
        for (int j = 0; j < 4; ++j) { v[j] = yr[64 * j]; s += (v[j][0] + v[j][1]) + (v[j][2] + v[j][3]); }
        const float mean = wave_sum(s) * (1.f / DM); float s2 = 0.f;
#pragma unroll
        for (int j = 0; j < 4; ++j) { v[j] = v[j] - mean; s2 += (v[j][0] * v[j][0] + v[j][1] * v[j][1]) + (v[j][2] * v[j][2] + v[j][3] * v[j][3]); }
        const float rstd = 1.f / sqrtf(wave_sum(s2) * (1.f / DM) + LN_EPS);
#pragma unroll
        for (int j = 0; j < 4; ++j) { const f32x4 gg = *((const f32x4*)ap->ln2_g + lane + 64 * j), bb = *((const f32x4*)ap->ln2_b + lane + 64 * j);
            yr[64 * j] = v[j] * rstd * gg + bb; }
    } }
}

extern "C" void kernel_launch(void* const* d_in, const int* in_sizes, int n_in, void* d_out, int out_size, void* d_ws, size_t ws_size, hipStream_t stream) {
    static int grid = 0;
    if (grid == 0) {
        if (n_in != 17 || in_sizes[0] != T * DM || out_size != T * DM || ws_size < WS_END) { fprintf(stderr, "kernel_launch: unexpected shapes / workspace (n_in %d, ws %zu)\n", n_in, ws_size); grid = -1; return; }
        int dev = 0, cus = 0, per_cu = 0;
        hipGetDevice(&dev); hipDeviceGetAttribute(&cus, hipDeviceAttributeMultiprocessorCount, dev);
        if (hipFuncSetAttribute((const void*)fwd_megakernel, hipFuncAttributeMaxDynamicSharedMemorySize, LDS_BYTES) != hipSuccess) { fprintf(stderr, "kernel_launch: hipFuncSetAttribute failed\n"); grid = -1; return; }
        if (hipOccupancyMaxActiveBlocksPerMultiprocessor(&per_cu, (const void*)fwd_megakernel, NTHR, LDS_BYTES) != hipSuccess || per_cu < 1) { fprintf(stderr, "kernel_launch: occupancy query says %d blocks per CU\n", per_cu); grid = -1; return; }
        grid = cus;
    }
    if (grid < 0) return;
    Args a{};
    a.x = (const float*)d_in[0]; a.c = (const float*)d_in[1]; a.w_ada = (const float*)d_in[2]; a.b_ada = (const float*)d_in[3]; a.w_in = (const float*)d_in[4];
    a.w_branch_att = (const float*)d_in[5]; a.w_pool_group = (const float*)d_in[6]; a.pool_scale = (const float*)d_in[7]; a.w_branch_pool = (const float*)d_in[8];
    a.w_out = (const float*)d_in[9]; a.ln1_g = (const float*)d_in[10]; a.ln1_b = (const float*)d_in[11]; a.w_gate = (const float*)d_in[12]; a.w_up = (const float*)d_in[13];
    a.w_down = (const float*)d_in[14]; a.ln2_g = (const float*)d_in[15]; a.ln2_b = (const float*)d_in[16];
    a.out = (float*)d_out; a.ws = (unsigned char*)d_ws;
    void* args[] = {&a};
    hipError_t e = hipLaunchCooperativeKernel((const void*)fwd_megakernel, dim3(grid), dim3(NTHR), args, LDS_BYTES, stream);
    if (e != hipSuccess) fprintf(stderr, "kernel_launch: cooperative launch failed: %s (grid %d)\n", hipGetErrorString(e), grid);
}
```

```cpp
#include <hip/hip_runtime.h>
#include <hip/hip_cooperative_groups.h>
#include <cstdio>
#include <cstdint>
namespace cg = cooperative_groups;

#define LAS __attribute__((address_space(3)))
typedef unsigned short bf16_t;
typedef short bf16x8 __attribute__((ext_vector_type(8)));
typedef short s16x4 __attribute__((ext_vector_type(4)));
typedef float f32x4 __attribute__((ext_vector_type(4)));
typedef unsigned u32x4 __attribute__((ext_vector_type(4)));
typedef unsigned u32x2 __attribute__((ext_vector_type(2)));

constexpr int DM = 1024, NB = 16, SEQ = 2048, T = NB * SEQ, INW = 5376, DFF = 2816, NMOD = 6144;
constexpr float LN_EPS = 1e-5f;
constexpr float ALPHA = 1.189207115002721f;
constexpr int NWAVES = 8, NTHR = 512;
constexpr int LDS_BYTES = 147456;

constexpr size_t MiB = 1u << 20;
constexpr size_t WS_WIN = 1 * MiB;
constexpr size_t WS_WA = WS_WIN + 11 * MiB;
constexpr size_t WS_WPG = WS_WA + 1 * MiB;
constexpr size_t WS_WBP = WS_WPG + 1 * MiB;
constexpr size_t WS_WO = WS_WBP + 2 * MiB;
constexpr size_t WS_WGU = WS_WO + 2 * MiB;
constexpr size_t WS_WD = WS_WGU + 11 * MiB;
constexpr size_t WS_MOD = WS_WD + 6 * MiB;
constexpr size_t WS_LSE = WS_MOD + 1 * MiB;
constexpr size_t WS_B = 40 * MiB;
constexpr size_t WS_C = 104 * MiB;
constexpr size_t WS_D = 248 * MiB;
constexpr size_t WS_E = 312 * MiB;
constexpr size_t WS_F = 440 * MiB;
constexpr size_t WS_G = 488 * MiB;
constexpr size_t WS_END = 504 * MiB;
static_assert(WS_LSE + 2 * MiB <= WS_B, "ws map");

typedef float f32x2_t __attribute__((ext_vector_type(2)));
typedef __bf16 bf16x2_t __attribute__((ext_vector_type(2)));
__device__ __forceinline__ unsigned cvt_pk_bf16(float lo, float hi) { const f32x2_t v = {lo, hi}; const bf16x2_t b = __builtin_convertvector(v, bf16x2_t); return __builtin_bit_cast(unsigned, b); }
__device__ __forceinline__ float wave_sum(float v) {
#pragma unroll
    for (int o = 1; o < 64; o <<= 1) v += __shfl_xor(v, o);
    return v;
}
__device__ __forceinline__ float fast_sigmoid(float v) { return __builtin_amdgcn_rcpf(1.0f + __expf(-v)); }
__device__ __forceinline__ int fresh_tid() { int t = threadIdx.x; asm volatile("" : "+v"(t)); return t; }
__device__ __forceinline__ float bf2f(unsigned short h) { return __uint_as_float(((unsigned)h) << 16); }

namespace pg8 {
constexpr int BM = 256, BK = 64, HALF = 128, HTB = HALF * BK * 2, STAGE_BYTES = 8 * HTB, NXCD = 8, WGM = 8;
__host__ __device__ __forceinline__ int lds_byte(int r, int c) { const int st = (r >> 4) * 2 + (c >> 5), rr = r & 15, cc = c & 31, ob = rr * 64 + cc * 2; return st * 1024 + (ob ^ (((ob >> 9) & 1) << 5)); }
__host__ __device__ __forceinline__ void stage_rc(int b, int& R, int& C) { const int st = b / 1024, sb = b % 1024, swz = sb ^ (((sb >> 9) & 1) << 5); R = (st >> 1) * 16 + swz / 64; C = (st & 1) * 32 + (swz % 64) / 2; }
__host__ __device__ __forceinline__ int perm32(int rho) { const int n = rho >> 4, i = rho & 15; return 8 * (i >> 2) + 4 * n + (i & 3); }

struct Unit { int pm, pn; };
struct Gemm { const bf16_t* A; const bf16_t* Bt; int lda, ldb, K, a_pn_off; };

struct StaticOrder {
    int nM, nN, nwg, G, c;
    __device__ void init(int M, int N, int G_, int c_) { nM = M / BM; nN = N / BM; nwg = nM * nN; G = G_; c = c_; }
    __device__ bool next(int i, Unit& u) const {
        const long L = (long)i * G + c; if (L >= nwg) return false;
        int wgid = (int)L; { const int q = nwg / NXCD, r = nwg % NXCD, xcd = wgid % NXCD, off = wgid / NXCD; wgid = (xcd < r ? xcd * (q + 1) : r * (q + 1) + (xcd - r) * q) + off; }
        const int nig = WGM * nN, gid = wgid / nig, fm = gid * WGM, gsz = (nM - fm) < WGM ? (nM - fm) : WGM;
        u.pm = fm + ((wgid % nig) % gsz); u.pn = (wgid % nig) / gsz; return true;
    }
};

template <class Epi>
__device__ __forceinline__ void gemm_phase(LAS unsigned char* lds, const Gemm g, const StaticOrder& S, const Epi& E) {
    const int tid = fresh_tid(), wid = __builtin_amdgcn_readfirstlane(tid >> 6), lane = tid & 63, wr = wid >> 2, wc = wid & 3, fr = lane & 15, fq = lane >> 4;
    const int K = g.K, nt = K / BK;
    unsigned voffA[2], voffB[2];
#pragma unroll
    for (int i = 0; i < 2; ++i) { int R, C; stage_rc(tid * 16 + i * 8192, R, C); const int Rb = (R & ~31) + perm32(R & 31);
        voffA[i] = (unsigned)(R * g.lda + C) * 2u; voffB[i] = (unsigned)(Rb * g.ldb + C) * 2u; }
    const size_t kstep = (size_t)(BK * 2);
    const size_t hstepA = (size_t)HALF * g.lda * 2, hstepB = (size_t)HALF * g.ldb * 2;
    const size_t tstepA = 2 * hstepA, tstepB = 2 * hstepB;
    const unsigned ldsw = (unsigned)wid * 1024u;
    const int aoff = lds_byte(wr * 64 + fr, fq * 8), boff = lds_byte(wc * 32 + fr, fq * 8);
#define PG8_SA(b, h) (((b) * 2 + (h)) * HTB)
#define PG8_SB(b, h) ((4 + (b) * 2 + (h)) * HTB)
#define PG8_STAGE(bufoff, gbase, voff) do { const char* _gb = (const char*)(gbase); asm volatile("" : "+s"(_gb)); _Pragma("unroll") for (int _i = 0; _i < 2; ++_i) \
        __builtin_amdgcn_global_load_lds((const unsigned*)(_gb + (voff)[_i]), (LAS unsigned*)(lds + (bufoff) + ldsw + _i * 8192), 16, 0, 0); } while (0)
#define PG8_LDA(dst, b, h) do { _Pragma("unroll") for (int m = 0; m < 4; ++m) _Pragma("unroll") for (int k = 0; k < 2; ++k) dst[m][k] = *(const LAS bf16x8*)(lds + PG8_SA(b, h) + aoff + m * 2048 + k * 1024); } while (0)
#define PG8_LDB(dst, b, h) do { _Pragma("unroll") for (int n = 0; n < 2; ++n) _Pragma("unroll") for (int k = 0; k < 2; ++k) dst[n][k] = *(const LAS bf16x8*)(lds + PG8_SB(b, h) + boff + n * 2048 + k * 1024); } while (0)
#define PG8_MMA(ai, bj, At, Bt) do { __builtin_amdgcn_s_setprio(1); _Pragma("unroll") for (int m = 0; m < 4; ++m) _Pragma("unroll") for (int n = 0; n < 2; ++n) _Pragma("unroll") for (int k = 0; k < 2; ++k) \
        acc[ai][bj][m][n] = __builtin_amdgcn_mfma_f32_16x16x32_bf16(Bt[n][k], At[m][k], acc[ai][bj][m][n], 0, 0, 0); __builtin_amdgcn_s_setprio(0); } while (0)
#define PG8_WAIT_V(n) asm volatile("s_waitcnt vmcnt(" #n ")" ::: "memory")
#define PG8_WAIT_L(n) asm volatile("s_waitcnt lgkmcnt(" #n ")" ::: "memory")
#define PG8_BAR __builtin_amdgcn_s_barrier()
#define PG8_SCHED __builtin_amdgcn_sched_barrier(0)
    Unit cur, nxt; int ui = 0;
    if (!S.next(0, cur)) return;
    f32x4 acc[2][2][4][2];
#pragma unroll
    for (int a = 0; a < 2; ++a)
#pragma unroll
        for (int b = 0; b < 2; ++b)
#pragma unroll
            for (int m = 0; m < 4; ++m)
#pragma unroll
                for (int n = 0; n < 2; ++n) acc[a][b][m][n] = (f32x4){0.f, 0.f, 0.f, 0.f};
    bf16x8 At[4][2], B0[2][2], B1[2][2];
    const char* cA = (const char*)g.A + (size_t)cur.pm * tstepA + (size_t)cur.pn * g.a_pn_off * 2; const char* cB = (const char*)g.Bt + (size_t)cur.pn * tstepB;
    PG8_STAGE(PG8_SB(0, 0), cB, voffB); PG8_STAGE(PG8_SA(0, 0), cA, voffA); PG8_STAGE(PG8_SB(0, 1), cB + hstepB, voffB); PG8_STAGE(PG8_SA(0, 1), cA + hstepA, voffA);
    if (wr == 1) PG8_BAR;
    PG8_WAIT_V(4); PG8_BAR;
    PG8_STAGE(PG8_SB(1, 0), cB + kstep, voffB); PG8_STAGE(PG8_SA(1, 0), cA + kstep, voffA); PG8_STAGE(PG8_SB(1, 1), cB + hstepB + kstep, voffB);
    PG8_WAIT_V(6); PG8_BAR;
    for (;;) {
        const bool has_next = S.next(ui + 1, nxt);
        const char* nA = has_next ? (const char*)g.A + (size_t)nxt.pm * tstepA + (size_t)nxt.pn * g.a_pn_off * 2 : cA; const char* nB = has_next ? (const char*)g.Bt + (size_t)nxt.pn * tstepB : cB;
        for (int t = 0; t < nt; t += 2) {
            const bool last = (t == nt - 2);
            const char* a1 = cA + (size_t)(t + 1) * kstep;
            const char* a2 = last ? nA : cA + (size_t)(t + 2) * kstep; const char* b2 = last ? nB : cB + (size_t)(t + 2) * kstep;
            const char* a3 = a2 + kstep; const char* b3 = b2 + kstep;
            PG8_LDB(B0, 0, 0); PG8_SCHED; PG8_LDA(At, 0, 0); PG8_STAGE(PG8_SA(1, 1), a1 + hstepA, voffA);
            PG8_WAIT_L(8); PG8_BAR; PG8_WAIT_L(0); PG8_MMA(0, 0, At, B0); PG8_BAR; PG8_SCHED;
            PG8_LDB(B1, 0, 1); PG8_STAGE(PG8_SB(0, 0), b2, voffB);
            PG8_BAR; PG8_WAIT_L(0); PG8_MMA(0, 1, At, B1); PG8_BAR;
            PG8_LDA(At, 0, 1); PG8_STAGE(PG8_SA(0, 0), a2, voffA);
            PG8_BAR; PG8_WAIT_L(0); PG8_MMA(1, 0, At, B0); PG8_BAR; PG8_SCHED;
            PG8_STAGE(PG8_SB(0, 1), b2 + hstepB, voffB);
            PG8_WAIT_V(6); PG8_BAR; PG8_MMA(1, 1, At, B1); PG8_BAR;
            PG8_LDB(B0, 1, 0); PG8_SCHED; PG8_LDA(At, 1, 0); PG8_STAGE(PG8_SA(0, 1), a2 + hstepA, voffA);
            PG8_WAIT_L(8); PG8_BAR; PG8_WAIT_L(0); PG8_MMA(0, 0, At, B0); PG8_BAR; PG8_SCHED;
            PG8_LDB(B1, 1, 1); PG8_STAGE(PG8_SB(1, 0), b3, voffB);
            PG8_BAR; PG8_WAIT_L(0); PG8_MMA(0, 1, At, B1); PG8_BAR;
            PG8_LDA(At, 1, 1); PG8_STAGE(PG8_SA(1, 0), a3, voffA);
            PG8_BAR; PG8_WAIT_L(0); PG8_MMA(1, 0, At, B0); PG8_BAR; PG8_SCHED;
            PG8_STAGE(PG8_SB(1, 1), b3 + hstepB, voffB);
            PG8_WAIT_V(6); PG8_BAR; PG8_MMA(1, 1, At, B1); PG8_BAR;
        }
        E(acc, cur, wr, wc, fr, fq);
        if (!has_next) break;
#pragma unroll
        for (int a = 0; a < 2; ++a)
#pragma unroll
            for (int b = 0; b < 2; ++b)
#pragma unroll
                for (int m = 0; m < 4; ++m)
#pragma unroll
                    for (int n = 0; n < 2; ++n) acc[a][b][m][n] = (f32x4){0.f, 0.f, 0.f, 0.f};
        cur = nxt; cA = nA; cB = nB; ++ui;
    }
    PG8_WAIT_V(0);
    if (wr == 0) PG8_BAR;
    PG8_BAR;
#undef PG8_SA
#undef PG8_SB
#undef PG8_STAGE
#undef PG8_LDA
#undef PG8_LDB
#undef PG8_MMA
#undef PG8_WAIT_V
#undef PG8_WAIT_L
#undef PG8_BAR
#undef PG8_SCHED
}
}
using pg8::Unit;

__device__ __forceinline__ u32x4 pack8(const f32x4 v0, const f32x4 v1) { u32x4 w; w.x = cvt_pk_bf16(v0[0], v0[1]); w.y = cvt_pk_bf16(v0[2], v0[3]); w.z = cvt_pk_bf16(v1[0], v1[1]); w.w = cvt_pk_bf16(v1[2], v1[3]); return w; }

struct EpiProj {
    bf16_t* qkv; bf16_t* poolin; bf16_t* sga; bf16_t* sgb;
    __device__ __forceinline__ void operator()(const f32x4 (&acc)[2][2][4][2], const Unit& u, int wr, int wc, int fr, int fq) const {
        const int pn = u.pn, row0 = u.pm * 256 + wr * 64 + fr, cw = wc * 32 + 8 * fq;
        if (pn < 9) {
            const int which = pn / 3, g = pn - 3 * which, sh = 2 * g; const float sc = which == 0 ? 0.125f : 1.0f;
            bf16_t* base = qkv + (size_t)which * ((size_t)T * 768) + (size_t)g * ((size_t)T * 256);
#pragma unroll
            for (int ai = 0; ai < 2; ++ai)
#pragma unroll
                for (int m = 0; m < 4; ++m) { const int row = row0 + ai * 128 + m * 16, b = row >> 11, s = row & 2047, i = s >> sh, r = s & ((1 << sh) - 1), drow = (b << 11) + r * (2048 >> sh) + i;
                    bf16_t* rowp = base + (size_t)drow * 256 + cw;
#pragma unroll
                    for (int bj = 0; bj < 2; ++bj) *(u32x4*)(rowp + bj * 128) = pack8(acc[ai][bj][m][0] * sc, acc[ai][bj][m][1] * sc); }
        } else if (pn < 13) {
            bf16_t* base = poolin + (pn - 9) * 256 + cw;
#pragma unroll
            for (int ai = 0; ai < 2; ++ai)
#pragma unroll
                for (int m = 0; m < 4; ++m) { bf16_t* rowp = base + (size_t)(row0 + ai * 128 + m * 16) * DM;
#pragma unroll
                    for (int bj = 0; bj < 2; ++bj) *(u32x4*)(rowp + bj * 128) = pack8(acc[ai][bj][m][0], acc[ai][bj][m][1]); }
        } else {
            bf16_t* base = (pn < 17 ? sga : sgb) + ((pn - 13) & 3) * 256 + cw;
#pragma unroll
            for (int ai = 0; ai < 2; ++ai)
#pragma unroll
                for (int m = 0; m < 4; ++m) { bf16_t* rowp = base + (size_t)(row0 + ai * 128 + m * 16) * DM;
#pragma unroll
                    for (int bj = 0; bj < 2; ++bj) { f32x4 v0 = acc[ai][bj][m][0], v1 = acc[ai][bj][m][1];
#pragma unroll
                        for (int j = 0; j < 4; ++j) { v0[j] = fast_sigmoid(v0[j]); v1[j] = fast_sigmoid(v1[j]); }
                        *(u32x4*)(rowp + bj * 128) = pack8(v0, v1); } }
        }
    }
};
struct EpiPg {
    bf16_t* out; const float* scale;
    __device__ __forceinline__ void operator()(const f32x4 (&acc)[2][2][4][2], const Unit& u, int wr, int wc, int fr, int fq) const {
        const int row0 = u.pm * 256 + wr * 64 + fr, col0 = u.pn * 256 + wc * 32 + 8 * fq;
        f32x4 sv[2][2];
#pragma unroll
        for (int bj = 0; bj < 2; ++bj) { sv[bj][0] = *(const f32x4*)(scale + col0 + bj * 128); sv[bj][1] = *(const f32x4*)(scale + col0 + bj * 128 + 4); }
#pragma unroll
        for (int ai = 0; ai < 2; ++ai)
#pragma unroll
            for (int m = 0; m < 4; ++m) { bf16_t* rowp = out + (size_t)(row0 + ai * 128 + m * 16) * DM + col0;
#pragma unroll
                for (int bj = 0; bj < 2; ++bj) *(u32x4*)(rowp + bj * 128) = pack8(acc[ai][bj][m][0] * sv[bj][0], acc[ai][bj][m][1] * sv[bj][1]); }
    }
};
__device__ __forceinline__ void unpack8(const u32x4 w, f32x4& a, f32x4& b) {
    a[0] = __uint_as_float(w.x << 16); a[1] = __uint_as_float(w.x & 0xffff0000u); a[2] = __uint_as_float(w.y << 16); a[3] = __uint_as_float(w.y & 0xffff0000u);
    b[0] = __uint_as_float(w.z << 16); b[1] = __uint_as_float(w.z & 0xffff0000u); b[2] = __uint_as_float(w.w << 16); b[3] = __uint_as_float(w.w & 0xffff0000u);
}
struct EpiBrA {
    float* tmp; const bf16_t* sg;
    __device__ __forceinline__ void operator()(const f32x4 (&acc)[2][2][4][2], const Unit& u, int wr, int wc, int fr, int fq) const {
        const int row0 = u.pm * 256 + wr * 64 + fr, col0 = u.pn * 256 + wc * 32 + 8 * fq;
#pragma unroll
        for (int ai = 0; ai < 2; ++ai)
#pragma unroll
            for (int m = 0; m < 4; ++m) { const size_t off = (size_t)(row0 + ai * 128 + m * 16) * DM + col0;
#pragma unroll
                for (int bj = 0; bj < 2; ++bj) { f32x4 g0, g1; unpack8(*(const u32x4*)(sg + off + bj * 128), g0, g1);
                    *(f32x4*)(tmp + off + bj * 128) = acc[ai][bj][m][0] * g0; *(f32x4*)(tmp + off + bj * 128 + 4) = acc[ai][bj][m][1] * g1; }
                asm volatile("" ::: "memory"); }
    }
};
struct EpiBrB {
    bf16_t* merged; const float* tmp; const bf16_t* sg;
    __device__ __forceinline__ void operator()(const f32x4 (&acc)[2][2][4][2], const Unit& u, int wr, int wc, int fr, int fq) const {
        const int row0 = u.pm * 256 + wr * 64 + fr, col0 = u.pn * 256 + wc * 32 + 8 * fq;
#pragma unroll
        for (int ai = 0; ai < 2; ++ai)
#pragma unroll
            for (int m = 0; m < 4; ++m) { const size_t off = (size_t)(row0 + ai * 128 + m * 16) * DM + col0;
#pragma unroll
                for (int bj = 0; bj < 2; ++bj) { f32x4 g0, g1; unpack8(*(const u32x4*)(sg + off + bj * 128), g0, g1);
                    const f32x4 t0 = *(const f32x4*)(tmp + off + bj * 128), t1 = *(const f32x4*)(tmp + off + bj * 128 + 4);
                    *(u32x4*)(merged + off + bj * 128) = pack8(t0 + acc[ai][bj][m][0] * g0, t1 + acc[ai][bj][m][1] * g1); }
                asm volatile("" ::: "memory"); }
    }
};
struct EpiRes {
    float* out; const float* res; const float* modv; int gate_off;
    __device__ __forceinline__ void operator()(const f32x4 (&acc)[2][2][4][2], const Unit& u, int wr, int wc, int fr, int fq) const {
        const int row0 = u.pm * 256 + wr * 64 + fr, col0 = u.pn * 256 + wc * 32 + 8 * fq;
        const float* gp = modv + (size_t)(u.pm >> 3) * NMOD + gate_off + col0;
        f32x4 gv[2][2];
#pragma unroll
        for (int bj = 0; bj < 2; ++bj) { gv[bj][0] = *(const f32x4*)(gp + bj * 128); gv[bj][1] = *(const f32x4*)(gp + bj * 128 + 4); }
#pragma unroll
        for (int ai = 0; ai < 2; ++ai)
#pragma unroll
            for (int m = 0; m < 4; ++m) { const size_t off = (size_t)(row0 + ai * 128 + m * 16) * DM + col0;
#pragma unroll
                for (int bj = 0; bj < 2; ++bj) { const f32x4 r0 = *(const f32x4*)(res + off + bj * 128), r1 = *(const f32x4*)(res + off + bj * 128 + 4);
                    *(f32x4*)(out + off + bj * 128) = r0 * ALPHA + acc[ai][bj][m][0] * gv[bj][0]; *(f32x4*)(out + off + bj * 128 + 4) = r1 * ALPHA + acc[ai][bj][m][1] * gv[bj][1]; }
                asm volatile("" ::: "memory"); }
    }
};
struct EpiGu {
    bf16_t* act;
    __device__ __forceinline__ void operator()(const f32x4 (&acc)[2][2][4][2], const Unit& u, int wr, int wc, int fr, int fq) const {
        const int row0 = u.pm * 256 + wr * 64 + fr, col0 = u.pn * 128 + wc * 32 + 8 * fq;
#pragma unroll
        for (int ai = 0; ai < 2; ++ai)
#pragma unroll
            for (int m = 0; m < 4; ++m) { f32x4 v0, v1;
#pragma unroll
                for (int j = 0; j < 4; ++j) { const float g0 = acc[ai][0][m][0][j], g1 = acc[ai][0][m][1][j];
                    v0[j] = g0 * fast_sigmoid(g0) * acc[ai][1][m][0][j]; v1[j] = g1 * fast_sigmoid(g1) * acc[ai][1][m][1][j]; }
                *(u32x4*)(act + (size_t)(row0 + ai * 128 + m * 16) * DFF + col0) = pack8(v0, v1); }
    }
};

constexpr int QS_OFF = 0, KS_OFF = 128 * 144, VS_OFF = KS_OFF + 256 * 144, ATT_ROWB = 144;
__device__ __forceinline__ void attn_unit(LAS unsigned char* lds, const bf16_t* QKV, bf16_t* ATTO, float* LSE, int unit, int tid, int wave, int lane) {
    const int rn = unit & 15, hs = (unit >> 4) & 3, bg = unit >> 6, g = bg % 3, b = bg / 3;
    const int sh = 2 * g, L = 2048 >> sh, nbs = 4 - sh;
    const int r = rn >> nbs, n = rn & ((1 << nbs) - 1);
    const size_t gbase = (size_t)g * ((size_t)T * 256);
    const int rowbase = b * 2048 + r * L;
    const bf16_t* Qg = QKV + gbase + (size_t)(rowbase + n * 128) * 256 + hs * 64;
    const bf16_t* Kg = QKV + (size_t)T * 768 + gbase + (size_t)rowbase * 256 + hs * 64;
    const bf16_t* Vg = QKV + 2 * (size_t)T * 768 + gbase + (size_t)rowbase * 256 + hs * 64;
    u32x4 rq[2], rk[4], rv[4];
#pragma unroll
    for (int i = 0; i < 2; ++i) { const int c = tid + 512 * i, row = c >> 3, part = c & 7; rq[i] = *(const u32x4*)(Qg + (size_t)row * 256 + part * 8); }
#pragma unroll
    for (int i = 0; i < 4; ++i) { const int c = tid + 512 * i, j = c >> 3, part = c & 7; int ik = n * 128 - 128 + j; if (ik < 0) ik += 128;
        rk[i] = *(const u32x4*)(Kg + (size_t)ik * 256 + part * 8); rv[i] = *(const u32x4*)(Vg + (size_t)ik * 256 + part * 8); }
    __syncthreads();
#pragma unroll
    for (int i = 0; i < 2; ++i) { const int c = tid + 512 * i, row = c >> 3, part = c & 7; *(LAS u32x4*)(lds + QS_OFF + row * ATT_ROWB + part * 16) = rq[i]; }
#pragma unroll
    for (int i = 0; i < 4; ++i) { const int c = tid + 512 * i, j = c >> 3, part = c & 7;
        *(LAS u32x4*)(lds + KS_OFF + j * ATT_ROWB + part * 16) = rk[i]; *(LAS u32x4*)(lds + VS_OFF + j * ATT_ROWB + part * 16) = rv[i]; }
    __syncthreads();
    const int fr = lane & 15, fq = lane >> 4;
    const int qrow = 16 * wave + fr, ks = (wave == 7) ? 96 : 16 * wave;
    bf16x8 qf[2];
#pragma unroll
    for (int k = 0; k < 2; ++k) qf[k] = *(const LAS bf16x8*)(lds + QS_OFF + qrow * ATT_ROWB + (32 * k + fq * 8) * 2);
    f32x4 sc[10];
#pragma unroll
    for (int kt = 0; kt < 10; ++kt) { f32x4 a = (f32x4){0.f, 0.f, 0.f, 0.f};
#pragma unroll
        for (int k = 0; k < 2; ++k) { const bf16x8 kf = *(const LAS bf16x8*)(lds + KS_OFF + (ks + 16 * kt + fr) * ATT_ROWB + (32 * k + fq * 8) * 2);
            a = __builtin_amdgcn_mfma_f32_16x16x32_bf16(kf, qf[k], a, 0, 0, 0); }
        sc[kt] = a; }
    const int hidx = g * 4 + hs;
    const float slope = hidx < 8 ? exp2f(-0.5f * (float)(hidx + 1)) : exp2f(-(float)(hidx - 3));
    const float LOG2E = 1.4426950408889634f;
    const float sl2 = slope * (float)(1 << sh) * LOG2E;
    float mx = -INFINITY;
#pragma unroll
    for (int kt = 0; kt < 10; ++kt)
#pragma unroll
        for (int j = 0; j < 4; ++j) { const int kj = ks + 16 * kt + 4 * fq + j, diff = 128 + qrow - kj;
            const bool valid = (diff >= 0) && (diff <= 128) && (n > 0 || kj >= 128);
            const float v = valid ? sc[kt][j] * LOG2E - sl2 * (float)diff : -INFINITY; sc[kt][j] = v; mx = fmaxf(mx, v); }
    mx = fmaxf(mx, __shfl_xor(mx, 16)); mx = fmaxf(mx, __shfl_xor(mx, 32));
    float l = 0.f;
#pragma unroll
    for (int kt = 0; kt < 10; ++kt)
#pragma unroll
        for (int j = 0; j < 4; ++j) { const float p = exp2f(sc[kt][j] - mx); sc[kt][j] = p; l += p; }
    l += __shfl_xor(l, 16); l += __shfl_xor(l, 32);
    bf16x8 pf[5];
#pragma unroll
    for (int pp = 0; pp < 5; ++pp) { const u32x4 w = pack8(sc[2 * pp], sc[2 * pp + 1]); pf[pp] = __builtin_bit_cast(bf16x8, w); }
    const float rl = 1.0f / l;
    const int q4 = fr >> 2, p4 = fr & 3;
    const int t = b * 2048 + ((n * 128 + qrow) << sh) + r;
    bf16_t* orow = ATTO + gbase + (size_t)t * 256 + hs * 64 + 4 * fq;
#pragma unroll
    for (int dt = 0; dt < 4; ++dt) { f32x4 o = (f32x4){0.f, 0.f, 0.f, 0.f};
#pragma unroll
        for (int pp = 0; pp < 5; ++pp) {
            const s16x4 lo = __builtin_amdgcn_ds_read_tr16_b64_v4i16((LAS s16x4*)(lds + VS_OFF + (ks + 32 * pp + 4 * fq + q4) * ATT_ROWB + (16 * dt + 4 * p4) * 2));
            const s16x4 hi = __builtin_amdgcn_ds_read_tr16_b64_v4i16((LAS s16x4*)(lds + VS_OFF + (ks + 32 * pp + 16 + 4 * fq + q4) * ATT_ROWB + (16 * dt + 4 * p4) * 2));
            const bf16x8 vf = __builtin_shufflevector(lo, hi, 0, 1, 2, 3, 4, 5, 6, 7);
            o = __builtin_amdgcn_mfma_f32_16x16x32_bf16(vf, pf[pp], o, 0, 0, 0); }
        u32x2 w; w.x = cvt_pk_bf16(o[0] * rl, o[1] * rl); w.y = cvt_pk_bf16(o[2] * rl, o[3] * rl);
        *(u32x2*)(orow + 16 * dt) = w; }
    if (fq == 0) LSE[((size_t)g * T + t) * 4 + hs] = (mx + log2f(l)) * 0.6931471805599453f;
}

template <int W>
__device__ __forceinline__ void pool_item(const bf16_t* POOLIN, bf16_t* PM, int pair, int g, int lane) {
    const int tok = pair * 2 + (lane >> 5), s = tok & 2047, col = g * 256 + (lane & 31) * 8;
    const bf16_t* p = POOLIN + (size_t)tok * DM + col;
    u32x4 v[W];
#pragma unroll
    for (int i = 0; i < W; ++i) { const int back = (i <= s) ? i : 0; v[i] = *(const u32x4*)(p - (size_t)back * DM); }
    f32x4 s0 = (f32x4){0.f, 0.f, 0.f, 0.f}, s1 = s0, u0, u1;
#pragma unroll
    for (int i = 0; i < W; ++i) { f32x4 a, bb; unpack8(v[i], a, bb); if (i == 0) { u0 = a; u1 = bb; } if (i <= s) { s0 += a; s1 += bb; } }
    const float rc = 1.0f / (float)((s + 1) < W ? (s + 1) : W);
    *(u32x4*)(PM + (size_t)tok * DM + col) = pack8(s0 * rc - u0, s1 * rc - u1);
}


#define XB_TMO      128
#define XB_XCNT(j)  (256  + 64 * (j))
#define XB_XSUB(j)  (1280 + 64 * (j))
#define XB_XGEN(j)  (2304 + 64 * (j))
#define XB_TOP      3328
#define XB_TOPGEN   3392
#define XCD_BAR_WORDS 3456
#define XB_SPIN_CAP (1u << 18)
__device__ __forceinline__ unsigned xb_ld(unsigned* p)              { return __hip_atomic_load(p, __ATOMIC_RELAXED, __HIP_MEMORY_SCOPE_AGENT); }
__device__ __forceinline__ unsigned xb_add(unsigned* p, unsigned v) { return __hip_atomic_fetch_add(p, v, __ATOMIC_RELAXED, __HIP_MEMORY_SCOPE_AGENT); }
__device__ __forceinline__ unsigned xb_xcc_id() { return (unsigned)__builtin_amdgcn_s_getreg((3 << 11) | 20) & 0xFu; }
#define XB_SPIN(cond, bar) do { unsigned _sp = 0; while (cond) { __builtin_amdgcn_s_sleep(1); \
    if ((++_sp & 255u) == 0u) { if (xb_ld(&(bar)[XB_TMO])) break; if (_sp > XB_SPIN_CAP) { atomicAdd(&(bar)[XB_TMO], 1u); break; } } } } while (0)
struct XcdBarrier { unsigned* bar; unsigned x; volatile LAS unsigned* st; };
__device__ __forceinline__ void xcd_barrier_complete(unsigned* bar, unsigned x, unsigned& nloc, unsigned& nx) {
    const unsigned G = gridDim.x * gridDim.y * gridDim.z;
    unsigned sum, cnt, mine, sp = 0u;
    for (;;) {
        sum = 0u; cnt = 0u; mine = 0u;
#pragma unroll
        for (unsigned j = 0; j < 16; ++j) { const unsigned c = xb_ld(&bar[XB_XCNT(j)]); sum += c; cnt += (c > 0u) ? 1u : 0u; mine = (j == x) ? c : mine; }
        if (sum == G) break;
        __builtin_amdgcn_s_sleep(1);
        if ((++sp & 255u) == 0u) { if (xb_ld(&bar[XB_TMO])) break; if (sp > XB_SPIN_CAP) { atomicAdd(&bar[XB_TMO], 1u); break; } }
    }
    nloc = mine > 0u ? mine : 1u; nx = cnt > 0u ? cnt : 1u;
}
__device__ __forceinline__ void xcd_barrier(const XcdBarrier& b) {
    asm volatile("s_waitcnt vmcnt(0)" ::: "memory");
    __syncthreads();
    if (threadIdx.x == 0) {
        unsigned* bar = b.bar;
        __builtin_amdgcn_s_waitcnt(0);
        unsigned nloc = b.st[0], nx = b.st[1];
        if (nloc == 0u) { xcd_barrier_complete(bar, b.x, nloc, nx); b.st[0] = nloc; b.st[1] = nx; }
        const unsigned old = xb_add(&bar[XB_XSUB(b.x)], 1u);
        const unsigned gen = old / nloc;
        if (old + 1u == (gen + 1u) * nloc) {
            __builtin_amdgcn_fence(__ATOMIC_RELEASE, "agent");
            asm volatile("s_waitcnt vmcnt(0)" ::: "memory");
            const unsigned og = xb_add(&bar[XB_TOP], 1u);
            const unsigned tg = og / nx;
            if (og + 1u == (tg + 1u) * nx) xb_add(&bar[XB_TOPGEN], 1u);
            else XB_SPIN(xb_ld(&bar[XB_TOPGEN]) == tg, bar);
            __builtin_amdgcn_fence(__ATOMIC_ACQUIRE, "agent");
            xb_add(&bar[XB_XGEN(b.x)], 1u);
            asm volatile("s_waitcnt vmcnt(0)" ::: "memory");
        } else {
            XB_SPIN(xb_ld(&bar[XB_XGEN(b.x)]) == gen, bar);
            __builtin_amdgcn_fence(__ATOMIC_ACQUIRE, "agent");
            asm volatile("s_waitcnt vmcnt(0)" ::: "memory");
        }
    }
    __syncthreads();
}
constexpr int MISC_OFF = 131072 + 320;
constexpr int BAR_WORD0 = 1024;

struct Args {
    const float* x; const float* c; const float* w_ada; const float* b_ada; const float* w_in; const float* w_branch_att; const float* w_pool_group; const float* pool_scale;
    const float* w_branch_pool; const float* w_out; const float* ln1_g; const float* ln1_b; const float* w_gate; const float* w_up; const float* w_down; const float* ln2_g; const float* ln2_b;
    float* out; unsigned char* ws;
};

#define CAS __attribute__((address_space(4)))
typedef const CAS Args* ArgsP;
__device__ __forceinline__ ArgsP fresh_args() { unsigned long long p = (unsigned long long)__builtin_amdgcn_kernarg_segment_ptr(); asm volatile("" : "+s"(p)); return (ArgsP)p; }

__device__ __forceinline__ void transpose_item(const float* W, int N, int k0, int n0, bf16_t* WT, int ldt, int drow0, LAS float* scr, int lane) {
#pragma unroll 8
    for (int i = 0; i < 32; ++i) { const int kk = 2 * i + (lane >> 5); scr[kk * 33 + (lane & 31)] = W[(size_t)(k0 + kk) * N + n0 + (lane & 31)]; }
    asm volatile("s_waitcnt lgkmcnt(0)" ::: "memory");
    const int c = lane & 7;
#pragma unroll
    for (int j = 0; j < 4; ++j) { const int n = (lane >> 3) + 8 * j; const LAS float* s = scr + (8 * c) * 33 + n;
        u32x4 o; o.x = cvt_pk_bf16(s[0 * 33], s[1 * 33]); o.y = cvt_pk_bf16(s[2 * 33], s[3 * 33]); o.z = cvt_pk_bf16(s[4 * 33], s[5 * 33]); o.w = cvt_pk_bf16(s[6 * 33], s[7 * 33]);
        *(u32x4*)(WT + (size_t)(drow0 + n) * ldt + k0 + 8 * c) = o; }
    asm volatile("s_waitcnt lgkmcnt(0)" ::: "memory");
}

__global__ void __launch_bounds__(NTHR, 2) fwd_megakernel(Args a) {
    extern __shared__ __attribute__((aligned(16))) unsigned char lds_raw[];
    cg::grid_group grid = cg::this_grid();
    LAS unsigned char* lds = (LAS unsigned char*)lds_raw;
    const int G = gridDim.x, NGW = G * NWAVES;
    if (threadIdx.x < 32) ((LAS unsigned*)(lds + MISC_OFF))[threadIdx.x] = 0u;
    __syncthreads();
    grid.sync();
    if (threadIdx.x == 0) (void)xb_add((unsigned*)(fresh_args()->ws) + BAR_WORD0 + XB_XCNT(xb_xcc_id()), 1u);
#define GRID_BAR() do { XcdBarrier b_; b_.bar = (unsigned*)(fresh_args()->ws) + BAR_WORD0; b_.x = xb_xcc_id(); b_.st = (volatile LAS unsigned*)(lds + MISC_OFF) + 8; xcd_barrier(b_); } while (0)
#define FRESH_IDS() const int tid = fresh_tid(), lane = tid & 63, wave = __builtin_amdgcn_readfirstlane(tid >> 6), gw = blockIdx.x * NWAVES + wave; (void)lane; (void)gw
#define PTRS() ArgsP ap = fresh_args(); unsigned char* ws = ap->ws; (void)ws
#define Win_t ((bf16_t*)(ws + WS_WIN))
#define Wa_t ((bf16_t*)(ws + WS_WA))
#define Wpg_t ((bf16_t*)(ws + WS_WPG))
#define Wbp_t ((bf16_t*)(ws + WS_WBP))
#define Wo_t ((bf16_t*)(ws + WS_WO))
#define Wgu_t ((bf16_t*)(ws + WS_WGU))
#define Wd_t ((bf16_t*)(ws + WS_WD))
#define MOD ((float*)(ws + WS_MOD))
#define LSE ((float*)(ws + WS_LSE))
#define H ((bf16_t*)(ws + WS_B))
#define PM H
#define MERGED H
#define H2 H
#define QKV ((bf16_t*)(ws + WS_C))
#define TMP ((float*)(ws + WS_C))
#define X1 ((float*)(ws + WS_C))
#define POOLIN ((bf16_t*)(ws + WS_D))
#define PG POOLIN
#define ACT POOLIN
#define SGA ((bf16_t*)(ws + WS_E))
#define SGB (SGA + (size_t)T * DM)
#define Y ((float*)(ws + WS_E))
#define ATTO ((bf16_t*)(ws + WS_F))
#define ATT ((bf16_t*)(ws + WS_G))

    if (blockIdx.x < 192) {
        FRESH_IDS(); PTRS();
        LAS float* sl = (LAS float*)lds;
        LAS float* red = (LAS float*)(lds + 65536);
        for (int idx = tid; idx < NB * DM; idx += NTHR) { const int b = idx >> 10, k = idx & 1023; const float v = ap->c[idx]; sl[k * 16 + b] = v / (1.0f + __expf(-v)); }
        __syncthreads();
        const int n0 = blockIdx.x * 32, col = lane & 31, kh = lane >> 5;
        float accm[16];
#pragma unroll
        for (int b = 0; b < 16; ++b) accm[b] = 0.f;
        const float* wp = ap->w_ada + (size_t)(wave * 128 + kh) * NMOD + n0 + col;
#pragma unroll 8
        for (int j = 0; j < 64; ++j) { const float w = wp[(size_t)(2 * j) * NMOD]; const int k = wave * 128 + 2 * j + kh;
            const LAS f32x4* s4 = (const LAS f32x4*)(sl + k * 16);
#pragma unroll
            for (int q = 0; q < 4; ++q) { const f32x4 sv = s4[q];
#pragma unroll
                for (int e = 0; e < 4; ++e) accm[q * 4 + e] += sv[e] * w; } }
#pragma unroll
        for (int b = 0; b < 16; ++b) { accm[b] += __shfl_xor(accm[b], 32); }
        if (kh == 0) {
#pragma unroll
            for (int b = 0; b < 16; ++b) red[(wave * 16 + b) * 32 + col] = accm[b]; }
        __syncthreads();
        { const int b = tid >> 5, cc = tid & 31; float v = ap->b_ada[n0 + cc];
#pragma unroll
          for (int w = 0; w < 8; ++w) v += red[(w * 16 + b) * 32 + cc];
          MOD[(size_t)b * NMOD + n0 + cc] = v; }
        __syncthreads();
    }
    {
        FRESH_IDS(); PTRS();
        LAS float* scr = (LAS float*)(lds + wave * 16384);
        for (int it = gw; it < 8192; it += NGW) {
            int r = it;
            if (r < 2688) { const int kb = r / 168, nb = r % 168; transpose_item(ap->w_in, INW, kb * 64, nb * 32, Win_t, DM, nb * 32, scr, lane); continue; } r -= 2688;
            if (r < 128) { const int kb = r / 32, nb = r % 32; transpose_item(ap->w_branch_att, DM, kb * 64, nb * 32, Wa_t, 256, nb * 32, scr, lane); continue; } r -= 128;
            if (r < 128) { const int gg = r >> 5, q = r & 31, kb = q / 8, nb = q % 8; transpose_item(ap->w_pool_group + gg * 65536, 256, kb * 64, nb * 32, Wpg_t + gg * 65536, 256, nb * 32, scr, lane); continue; } r -= 128;
            if (r < 512) { const int kb = r / 32, nb = r % 32; transpose_item(ap->w_branch_pool, DM, kb * 64, nb * 32, Wbp_t, DM, nb * 32, scr, lane); continue; } r -= 512;
            if (r < 512) { const int kb = r / 32, nb = r % 32; transpose_item(ap->w_out, DM, kb * 64, nb * 32, Wo_t, DM, nb * 32, scr, lane); continue; } r -= 512;
            if (r < 1408) { const int kb = r / 88, nb = r % 88, n0 = nb * 32; transpose_item(ap->w_gate, DFF, kb * 64, n0, Wgu_t, DM, (n0 >> 7) * 256 + (n0 & 127), scr, lane); continue; } r -= 1408;
            if (r < 1408) { const int kb = r / 88, nb = r % 88, n0 = nb * 32; transpose_item(ap->w_up, DFF, kb * 64, n0, Wgu_t, DM, (n0 >> 7) * 256 + 128 + (n0 & 127), scr, lane); continue; } r -= 1408;
            { const int kb = r / 32, nb = r % 32; transpose_item(ap->w_down, DM, kb * 64, nb * 32, Wd_t, DFF, nb * 32, scr, lane); }
        }
    }
    GRID_BAR();

    { FRESH_IDS(); PTRS();
    for (int m = gw; m < T; m += NGW) {
        const float* mr = MOD + (size_t)(m >> 11) * NMOD;
        const f32x4* xr = (const f32x4*)(ap->x + (size_t)m * DM) + lane;
        unsigned long long* o8 = (unsigned long long*)(H + (size_t)m * DM) + lane;
#pragma unroll
        for (int j = 0; j < 4; ++j) { const f32x4 v = xr[64 * j]; const f32x4 sh = *((const f32x4*)(mr) + lane + 64 * j), sc = *((const f32x4*)(mr + 1024) + lane + 64 * j);
            const f32x4 h = v * (sc + 1.0f) + sh;
            o8[64 * j] = (unsigned long long)cvt_pk_bf16(h[0], h[1]) | ((unsigned long long)cvt_pk_bf16(h[2], h[3]) << 32); }
    } }
    GRID_BAR();

    { PTRS(); pg8::Gemm g{H, Win_t, DM, DM, DM, 0}; pg8::StaticOrder S; S.init(T, INW, G, (int)blockIdx.x);
      EpiProj E{QKV, POOLIN, SGA, SGB}; pg8::gemm_phase(lds, g, S, E); }
    GRID_BAR();

    { FRESH_IDS(); PTRS();
    for (int u = blockIdx.x; u < 3072; u += G) attn_unit(lds, QKV, ATTO, LSE, u, tid, wave, lane); }
    { FRESH_IDS(); PTRS();
    for (int k = 0; k < 32; ++k) {
        const int gsel = (k + gw) & 3, pair = gw + NGW * (k >> 2);
        if (pair < T / 2) {
            if (gsel == 0) pool_item<2>(POOLIN, PM, pair, 0, lane); else if (gsel == 1) pool_item<4>(POOLIN, PM, pair, 1, lane);
            else if (gsel == 2) pool_item<8>(POOLIN, PM, pair, 2, lane); else pool_item<16>(POOLIN, PM, pair, 3, lane);
        }
    } }
    __syncthreads();
    GRID_BAR();

    { PTRS(); pg8::Gemm g{PM, Wpg_t, DM, 256, 256, 256}; pg8::StaticOrder S; S.init(T, DM, G, (int)blockIdx.x);
      EpiPg E{PG, ap->pool_scale}; pg8::gemm_phase(lds, g, S, E); }
    { FRESH_IDS(); PTRS();
    for (int m = gw; m < T; m += NGW) {
        const int hs = lane >> 4;
        const float l0 = LSE[((size_t)0 * T + m) * 4 + hs], l1 = LSE[((size_t)1 * T + m) * 4 + hs], l2 = LSE[((size_t)2 * T + m) * 4 + hs];
        const float mxl = fmaxf(l0, fmaxf(l1, l2));
        const float e0 = __expf(l0 - mxl), e1 = __expf(l1 - mxl), e2 = __expf(l2 - mxl), rs = 1.0f / (e0 + e1 + e2);
        const float w0 = e0 * rs, w1 = e1 * rs, w2 = e2 * rs;
        const u32x2 a0 = *((const u32x2*)(ATTO + (size_t)m * 256) + lane), a1 = *((const u32x2*)(ATTO + (size_t)T * 256 + (size_t)m * 256) + lane), a2 = *((const u32x2*)(ATTO + 2 * (size_t)T * 256 + (size_t)m * 256) + lane);
        float o[4];
        o[0] = w0 * __uint_as_float(a0.x << 16) + w1 * __uint_as_float(a1.x << 16) + w2 * __uint_as_float(a2.x << 16);
        o[1] = w0 * __uint_as_float(a0.x & 0xffff0000u) + w1 * __uint_as_float(a1.x & 0xffff0000u) + w2 * __uint_as_float(a2.x & 0xffff0000u);
        o[2] = w0 * __uint_as_float(a0.y << 16) + w1 * __uint_as_float(a1.y << 16) + w2 * __uint_as_float(a2.y << 16);
        o[3] = w0 * __uint_as_float(a0.y & 0xffff0000u) + w1 * __uint_as_float(a1.y & 0xffff0000u) + w2 * __uint_as_float(a2.y & 0xffff0000u);
        u32x2 w; w.x = cvt_pk_bf16(o[0], o[1]); w.y = cvt_pk_bf16(o[2], o[3]);
        *((u32x2*)(ATT + (size_t)m * 256) + lane) = w;
    } }
    GRID_BAR();

    { PTRS(); pg8::Gemm g{ATT, Wa_t, 256, 256, 256, 0}; pg8::StaticOrder S; S.init(T, DM, G, (int)blockIdx.x);
      EpiBrA E{TMP, SGA}; pg8::gemm_phase(lds, g, S, E); }
    { PTRS(); pg8::Gemm g{PG, Wbp_t, DM, DM, DM, 0}; pg8::StaticOrder S; S.init(T, DM, G, (int)blockIdx.x);
      EpiBrB E{MERGED, TMP, SGB}; pg8::gemm_phase(lds, g, S, E); }
    GRID_BAR();

    { PTRS(); pg8::Gemm g{MERGED, Wo_t, DM, DM, DM, 0}; pg8::StaticOrder S; S.init(T, DM, G, (int)blockIdx.x);
      EpiRes E{Y, ap->x, MOD, 2048}; pg8::gemm_phase(lds, g, S, E); }
    GRID_BAR();

    { FRESH_IDS(); PTRS();
    for (int m = gw; m < T; m += NGW) {
        const float* mr = MOD + (size_t)(m >> 11) * NMOD;
        const f32x4* yr = (const f32x4*)(Y + (size_t)m * DM) + lane;
        f32x4 v[4]; float s = 0.f;
#pragma unroll
        for (int j = 0; j < 4; ++j) { v[j] = yr[64 * j]; s += (v[j][0] + v[j][1]) + (v[j][2] + v[j][3]); }
        const float mean = wave_sum(s) * (1.f / DM); float s2 = 0.f;
#pragma unroll
        for (int j = 0; j < 4; ++j) { v[j] = v[j] - mean; s2 += (v[j][0] * v[j][0] + v[j][1] * v[j][1]) + (v[j][2] * v[j][2] + v[j][3] * v[j][3]); }
        const float rstd = 1.f / sqrtf(wave_sum(s2) * (1.f / DM) + LN_EPS);
        f32x4* xo = (f32x4*)(X1 + (size_t)m * DM) + lane;
        unsigned long long* o8 = (unsigned long long*)(H2 + (size_t)m * DM) + lane;
#pragma unroll
        for (int j = 0; j < 4; ++j) { const f32x4 gg = *((const f32x4*)ap->ln1_g + lane + 64 * j), bb = *((const f32x4*)ap->ln1_b + lane + 64 * j);
            const f32x4 x1 = v[j] * rstd * gg + bb; xo[64 * j] = x1;
            const f32x4 sh = *((const f32x4*)(mr + 3072) + lane + 64 * j), sc = *((const f32x4*)(mr + 4096) + lane + 64 * j);
            const f32x4 h = x1 * (sc + 1.0f) + sh;
            o8[64 * j] = (unsigned long long)cvt_pk_bf16(h[0], h[1]) | ((unsigned long long)cvt_pk_bf16(h[2], h[3]) << 32); }
    } }
    GRID_BAR();

    { PTRS(); pg8::Gemm g{H2, Wgu_t, DM, DM, DM, 0}; pg8::StaticOrder S; S.init(T, 2 * DFF, G, (int)blockIdx.x);
      EpiGu E{ACT}; pg8::gemm_phase(lds, g, S, E); }
    GRID_BAR();

    { PTRS(); pg8::Gemm g{ACT, Wd_t, DFF, DFF, DFF, 0}; pg8::StaticOrder S; S.init(T, DM, G, (int)blockIdx.x);
      EpiRes E{ap->out, X1, MOD, 5120}; pg8::gemm_phase(lds, g, S, E); }
    GRID_BAR();

    { FRESH_IDS(); PTRS();
    for (int m = gw; m < T; m += NGW) {
        f32x4* yr = (f32x4*)(ap->out + (size_t)m * DM) + lane;
        f32x4 v[4]; float s = 0.f;
#pragma unroll
        for (int j = 0; j < 4; ++j) { v[j] = yr[64 * j]; s += (v[j][0] + v[j][1]) + (v[j][2] + v[j][3]); }
        const float mean = wave_sum(s) * (1.f / DM); float s2 = 0.f;
#pragma unroll
        for (int j = 0; j < 4; ++j) { v[j] = v[j] - mean; s2 += (v[j][0] * v[j][0] + v[j][1] * v[j][1]) + (v[j][2] * v[j][2] + v[j][3] * v[j][3]); }
        const float rstd = 1.f / sqrtf(wave_sum(s2) * (1.f / DM) + LN_EPS);
#pragma unroll
        for (int j = 0; j < 4; ++j) { const f32x4 gg = *((const f32x4*)ap->ln2_g + lane + 64 * j), bb = *((const f32x4*)ap->ln2_b + lane + 64 * j);
            yr[64 * j] = v[j] * rstd * gg + bb; }
    } }
}

extern "C" void kernel_launch(void* const* d_in, const int* in_sizes, int n_in, void* d_out, int out_size, void* d_ws, size_t ws_size, hipStream_t stream) {
    static int grid = 0;
    if (grid == 0) {
        if (n_in != 17 || in_sizes[0] != T * DM || out_size != T * DM || ws_size < WS_END) { fprintf(stderr, "kernel_launch: unexpected shapes / workspace (n_in %d, ws %zu)\n", n_in, ws_size); grid = -1; return; }
        int dev = 0, cus = 0, per_cu = 0;
        hipGetDevice(&dev); hipDeviceGetAttribute(&cus, hipDeviceAttributeMultiprocessorCount, dev);
        if (hipFuncSetAttribute((const void*)fwd_megakernel, hipFuncAttributeMaxDynamicSharedMemorySize, LDS_BYTES) != hipSuccess) { fprintf(stderr, "kernel_launch: hipFuncSetAttribute failed\n"); grid = -1; return; }
        if (hipOccupancyMaxActiveBlocksPerMultiprocessor(&per_cu, (const void*)fwd_megakernel, NTHR, LDS_BYTES) != hipSuccess || per_cu < 1) { fprintf(stderr, "kernel_launch: occupancy query says %d blocks per CU\n", per_cu); grid = -1; return; }
        grid = cus;
    }
    if (grid < 0) return;
    Args a{};
    a.x = (const float*)d_in[0]; a.c = (const float*)d_in[1]; a.w_ada = (const float*)d_in[2]; a.b_ada = (const float*)d_in[3]; a.w_in = (const float*)d_in[4];
    a.w_branch_att = (const float*)d_in[5]; a.w_pool_group = (const float*)d_in[6]; a.pool_scale = (const float*)d_in[7]; a.w_branch_pool = (const float*)d_in[8];
    a.w_out = (const float*)d_in[9]; a.ln1_g = (const float*)d_in[10]; a.ln1_b = (const float*)d_in[11]; a.w_gate = (const float*)d_in[12]; a.w_up = (const float*)d_in[13];
    a.w_down = (const float*)d_in[14]; a.ln2_g = (const float*)d_in[15]; a.ln2_b = (const float*)d_in[16];
    a.out = (float*)d_out; a.ws = (unsigned char*)d_ws;
    if (hipMemsetAsync(d_ws, 0, 65536, stream) != hipSuccess) { fprintf(stderr, "kernel_launch: hipMemsetAsync failed\n"); return; }
    void* args[] = {&a};
    hipError_t e = hipLaunchCooperativeKernel((const void*)fwd_megakernel, dim3(grid), dim3(NTHR), args, LDS_BYTES, stream);
    if (e != hipSuccess) fprintf(stderr, "kernel_launch: cooperative launch failed: %s (grid %d)\n", hipGetErrorString(e), grid);
}
```

```cpp
#include <hip/hip_runtime.h>
#include <hip/hip_cooperative_groups.h>
#include <cstdio>
#include <cstdint>
namespace cg = cooperative_groups;

#define LAS __attribute__((address_space(3)))
typedef unsigned short bf16_t;
typedef short bf16x8 __attribute__((ext_vector_type(8)));
typedef short s16x4 __attribute__((ext_vector_type(4)));
typedef float f32x4 __attribute__((ext_vector_type(4)));
typedef unsigned u32x4 __attribute__((ext_vector_type(4)));
typedef unsigned u32x2 __attribute__((ext_vector_type(2)));

constexpr int DM = 1024, NB = 16, SEQ = 2048, T = NB * SEQ, INW = 5376, DFF = 2816, NMOD = 6144;
constexpr float LN_EPS = 1e-5f;
constexpr float ALPHA = 1.189207115002721f;
constexpr int NWAVES = 8, NTHR = 512;
constexpr int LDS_BYTES = 147456;

constexpr size_t MiB = 1u << 20;
constexpr size_t WS_WIN = 1 * MiB;
constexpr size_t WS_WCAT = WS_WIN + 11 * MiB;
constexpr size_t WS_WPG = WS_WCAT + 3 * MiB;
constexpr size_t WS_WO = WS_WPG + 1 * MiB;
constexpr size_t WS_WGU = WS_WO + 2 * MiB;
constexpr size_t WS_WD = WS_WGU + 11 * MiB;
constexpr size_t WS_MOD = WS_WD + 6 * MiB;
constexpr size_t WS_LSE = WS_MOD + 1 * MiB;
constexpr size_t WS_B = 40 * MiB;
constexpr size_t WS_C = 104 * MiB;
constexpr size_t WS_D = 248 * MiB;
constexpr size_t WS_E = 312 * MiB;
constexpr size_t WS_F = 440 * MiB;
constexpr size_t WS_G = 488 * MiB;
constexpr size_t WS_END = 504 * MiB;
static_assert(WS_LSE + 2 * MiB <= WS_B, "ws map");

typedef float f32x2_t __attribute__((ext_vector_type(2)));
typedef __bf16 bf16x2_t __attribute__((ext_vector_type(2)));
__device__ __forceinline__ unsigned cvt_pk_bf16(float lo, float hi) { const f32x2_t v = {lo, hi}; const bf16x2_t b = __builtin_convertvector(v, bf16x2_t); return __builtin_bit_cast(unsigned, b); }
__device__ __forceinline__ float wave_sum(float v) {
#pragma unroll
    for (int o = 1; o < 64; o <<= 1) v += __shfl_xor(v, o);
    return v;
}
__device__ __forceinline__ float fast_sigmoid(float v) { return __builtin_amdgcn_rcpf(1.0f + __expf(-v)); }
__device__ __forceinline__ int fresh_tid() { int t = threadIdx.x; asm volatile("" : "+v"(t)); return t; }
__device__ __forceinline__ float bf2f(unsigned short h) { return __uint_as_float(((unsigned)h) << 16); }

namespace pg8 {
constexpr int BM = 256, BK = 64, HALF = 128, HTB = HALF * BK * 2, STAGE_BYTES = 8 * HTB, NXCD = 8, WGM = 8;
__host__ __device__ __forceinline__ int lds_byte(int r, int c) { const int st = (r >> 4) * 2 + (c >> 5), rr = r & 15, cc = c & 31, ob = rr * 64 + cc * 2; return st * 1024 + (ob ^ (((ob >> 9) & 1) << 5)); }
__host__ __device__ __forceinline__ void stage_rc(int b, int& R, int& C) { const int st = b / 1024, sb = b % 1024, swz = sb ^ (((sb >> 9) & 1) << 5); R = (st >> 1) * 16 + swz / 64; C = (st & 1) * 32 + (swz % 64) / 2; }
__host__ __device__ __forceinline__ int perm32(int rho) { const int n = rho >> 4, i = rho & 15; return 8 * (i >> 2) + 4 * n + (i & 3); }

struct Unit { int pm, pn; };
struct Gemm { const bf16_t* A; const bf16_t* Bt; int lda, ldb, K, a_pn_off; };

struct StaticOrder {
    int nM, nN, nwg, G, c;
    __device__ void init(int M, int N, int G_, int c_) { nM = M / BM; nN = N / BM; nwg = nM * nN; G = G_; c = c_; }
    __device__ bool next(int i, Unit& u) const {
        const long L = (long)i * G + c; if (L >= nwg) return false;
        int wgid = (int)L; { const int q = nwg / NXCD, r = nwg % NXCD, xcd = wgid % NXCD, off = wgid / NXCD; wgid = (xcd < r ? xcd * (q + 1) : r * (q + 1) + (xcd - r) * q) + off; }
        const int nig = WGM * nN, gid = wgid / nig, fm = gid * WGM, gsz = (nM - fm) < WGM ? (nM - fm) : WGM;
        u.pm = fm + ((wgid % nig) % gsz); u.pn = (wgid % nig) / gsz; return true;
    }
};

template <class Epi>
__device__ __forceinline__ void gemm_phase(LAS unsigned char* lds, const Gemm g, const StaticOrder& S, const Epi& E) {
    const int tid = fresh_tid(), wid = __builtin_amdgcn_readfirstlane(tid >> 6), lane = tid & 63, wr = wid >> 2, wc = wid & 3, fr = lane & 15, fq = lane >> 4;
    const int K = g.K, nt = K / BK;
    unsigned voffA[2], voffB[2];
#pragma unroll
    for (int i = 0; i < 2; ++i) { int R, C; stage_rc(tid * 16 + i * 8192, R, C); const int Rb = (R & ~31) + perm32(R & 31);
        voffA[i] = (unsigned)(R * g.lda + C) * 2u; voffB[i] = (unsigned)(Rb * g.ldb + C) * 2u; }
    const size_t kstep = (size_t)(BK * 2);
    const size_t hstepA = (size_t)HALF * g.lda * 2, hstepB = (size_t)HALF * g.ldb * 2;
    const size_t tstepA = 2 * hstepA, tstepB = 2 * hstepB;
    const unsigned ldsw = (unsigned)wid * 1024u;
    const int aoff = lds_byte(wr * 64 + fr, fq * 8), boff = lds_byte(wc * 32 + fr, fq * 8);
#define PG8_SA(b, h) (((b) * 2 + (h)) * HTB)
#define PG8_SB(b, h) ((4 + (b) * 2 + (h)) * HTB)
#define PG8_STAGE(bufoff, gbase, voff) do { const char* _gb = (const char*)(gbase); asm volatile("" : "+s"(_gb)); _Pragma("unroll") for (int _i = 0; _i < 2; ++_i) \
        __builtin_amdgcn_global_load_lds((const unsigned*)(_gb + (voff)[_i]), (LAS unsigned*)(lds + (bufoff) + ldsw + _i * 8192), 16, 0, 0); } while (0)
#define PG8_LDA(dst, b, h) do { _Pragma("unroll") for (int m = 0; m < 4; ++m) _Pragma("unroll") for (int k = 0; k < 2; ++k) dst[m][k] = *(const LAS bf16x8*)(lds + PG8_SA(b, h) + aoff + m * 2048 + k * 1024); } while (0)
#define PG8_LDB(dst, b, h) do { _Pragma("unroll") for (int n = 0; n < 2; ++n) _Pragma("unroll") for (int k = 0; k < 2; ++k) dst[n][k] = *(const LAS bf16x8*)(lds + PG8_SB(b, h) + boff + n * 2048 + k * 1024); } while (0)
#define PG8_MMA(ai, bj, At, Bt) do { __builtin_amdgcn_s_setprio(1); _Pragma("unroll") for (int m = 0; m < 4; ++m) _Pragma("unroll") for (int n = 0; n < 2; ++n) _Pragma("unroll") for (int k = 0; k < 2; ++k) \
        acc[ai][bj][m][n] = __builtin_amdgcn_mfma_f32_16x16x32_bf16(Bt[n][k], At[m][k], acc[ai][bj][m][n], 0, 0, 0); __builtin_amdgcn_s_setprio(0); } while (0)
#define PG8_WAIT_V(n) asm volatile("s_waitcnt vmcnt(" #n ")" ::: "memory")
#define PG8_WAIT_L(n) asm volatile("s_waitcnt lgkmcnt(" #n ")" ::: "memory")
#define PG8_BAR __builtin_amdgcn_s_barrier()
#define PG8_SCHED __builtin_amdgcn_sched_barrier(0)
    Unit cur, nxt; int ui = 0;
    if (!S.next(0, cur)) return;
    f32x4 acc[2][2][4][2];
#pragma unroll
    for (int a = 0; a < 2; ++a)
#pragma unroll
        for (int b = 0; b < 2; ++b)
#pragma unroll
            for (int m = 0; m < 4; ++m)
#pragma unroll
                for (int n = 0; n < 2; ++n) acc[a][b][m][n] = (f32x4){0.f, 0.f, 0.f, 0.f};
    bf16x8 At[4][2], B0[2][2], B1[2][2];
    const char* cA = (const char*)g.A + (size_t)cur.pm * tstepA + (size_t)cur.pn * g.a_pn_off * 2; const char* cB = (const char*)g.Bt + (size_t)cur.pn * tstepB;
    PG8_STAGE(PG8_SB(0, 0), cB, voffB); PG8_STAGE(PG8_SA(0, 0), cA, voffA); PG8_STAGE(PG8_SB(0, 1), cB + hstepB, voffB); PG8_STAGE(PG8_SA(0, 1), cA + hstepA, voffA);
    if (wr == 1) PG8_BAR;
    PG8_WAIT_V(4); PG8_BAR;
    PG8_STAGE(PG8_SB(1, 0), cB + kstep, voffB); PG8_STAGE(PG8_SA(1, 0), cA + kstep, voffA); PG8_STAGE(PG8_SB(1, 1), cB + hstepB + kstep, voffB);
    PG8_WAIT_V(6); PG8_BAR;
    for (;;) {
        const bool has_next = S.next(ui + 1, nxt);
        const char* nA = has_next ? (const char*)g.A + (size_t)nxt.pm * tstepA + (size_t)nxt.pn * g.a_pn_off * 2 : cA; const char* nB = has_next ? (const char*)g.Bt + (size_t)nxt.pn * tstepB : cB;
        for (int t = 0; t < nt; t += 2) {
            const bool last = (t == nt - 2);
            if constexpr (Epi::HOOK_T >= 0) { if (t == Epi::HOOK_T) E.hook(acc, cur, wr, wc, fr, fq); }
            const char* a1 = cA + (size_t)(t + 1) * kstep;
            const char* a2 = last ? nA : cA + (size_t)(t + 2) * kstep; const char* b2 = last ? nB : cB + (size_t)(t + 2) * kstep;
            const char* a3 = a2 + kstep; const char* b3 = b2 + kstep;
            PG8_LDB(B0, 0, 0); PG8_SCHED; PG8_LDA(At, 0, 0); PG8_STAGE(PG8_SA(1, 1), a1 + hstepA, voffA);
            PG8_WAIT_L(8); PG8_BAR; PG8_WAIT_L(0); PG8_MMA(0, 0, At, B0); PG8_BAR; PG8_SCHED;
            PG8_LDB(B1, 0, 1); PG8_STAGE(PG8_SB(0, 0), b2, voffB);
            PG8_BAR; PG8_WAIT_L(0); PG8_MMA(0, 1, At, B1); PG8_BAR;
            PG8_LDA(At, 0, 1); PG8_STAGE(PG8_SA(0, 0), a2, voffA);
            PG8_BAR; PG8_WAIT_L(0); PG8_MMA(1, 0, At, B0); PG8_BAR; PG8_SCHED;
            PG8_STAGE(PG8_SB(0, 1), b2 + hstepB, voffB);
            PG8_WAIT_V(6); PG8_BAR; PG8_MMA(1, 1, At, B1); PG8_BAR;
            PG8_LDB(B0, 1, 0); PG8_SCHED; PG8_LDA(At, 1, 0); PG8_STAGE(PG8_SA(0, 1), a2 + hstepA, voffA);
            PG8_WAIT_L(8); PG8_BAR; PG8_WAIT_L(0); PG8_MMA(0, 0, At, B0); PG8_BAR; PG8_SCHED;
            PG8_LDB(B1, 1, 1); PG8_STAGE(PG8_SB(1, 0), b3, voffB);
            PG8_BAR; PG8_WAIT_L(0); PG8_MMA(0, 1, At, B1); PG8_BAR;
            PG8_LDA(At, 1, 1); PG8_STAGE(PG8_SA(1, 0), a3, voffA);
            PG8_BAR; PG8_WAIT_L(0); PG8_MMA(1, 0, At, B0); PG8_BAR; PG8_SCHED;
            PG8_STAGE(PG8_SB(1, 1), b3 + hstepB, voffB);
            PG8_WAIT_V(6); PG8_BAR; PG8_MMA(1, 1, At, B1); PG8_BAR;
        }
        E(acc, cur, wr, wc, fr, fq);
        if (!has_next) break;
#pragma unroll
        for (int a = 0; a < 2; ++a)
#pragma unroll
            for (int b = 0; b < 2; ++b)
#pragma unroll
                for (int m = 0; m < 4; ++m)
#pragma unroll
                    for (int n = 0; n < 2; ++n) acc[a][b][m][n] = (f32x4){0.f, 0.f, 0.f, 0.f};
        cur = nxt; cA = nA; cB = nB; ++ui;
    }
    PG8_WAIT_V(0);
    if (wr == 0) PG8_BAR;
    PG8_BAR;
#undef PG8_SA
#undef PG8_SB
#undef PG8_STAGE
#undef PG8_LDA
#undef PG8_LDB
#undef PG8_MMA
#undef PG8_WAIT_V
#undef PG8_WAIT_L
#undef PG8_BAR
#undef PG8_SCHED
}
}
using pg8::Unit;

__device__ __forceinline__ u32x4 pack8(const f32x4 v0, const f32x4 v1) { u32x4 w; w.x = cvt_pk_bf16(v0[0], v0[1]); w.y = cvt_pk_bf16(v0[2], v0[3]); w.z = cvt_pk_bf16(v1[0], v1[1]); w.w = cvt_pk_bf16(v1[2], v1[3]); return w; }

struct EpiProj {
    static constexpr int HOOK_T = -1;
    bf16_t* qkv; bf16_t* poolin; bf16_t* sga; bf16_t* sgb;
    __device__ __forceinline__ void operator()(const f32x4 (&acc)[2][2][4][2], const Unit& u, int wr, int wc, int fr, int fq) const {
        const int pn = u.pn, row0 = u.pm * 256 + wr * 64 + fr, cw = wc * 32 + 8 * fq;
        if (pn < 9) {
            const int which = pn / 3, g = pn - 3 * which, sh = 2 * g; const float sc = which == 0 ? 0.125f : 1.0f;
            bf16_t* base = qkv + (size_t)which * ((size_t)T * 768) + (size_t)g * ((size_t)T * 256);
#pragma unroll
            for (int ai = 0; ai < 2; ++ai)
#pragma unroll
                for (int m = 0; m < 4; ++m) { const int row = row0 + ai * 128 + m * 16, b = row >> 11, s = row & 2047, i = s >> sh, r = s & ((1 << sh) - 1), drow = (b << 11) + r * (2048 >> sh) + i;
                    bf16_t* rowp = base + (size_t)drow * 256 + cw;
#pragma unroll
                    for (int bj = 0; bj < 2; ++bj) *(u32x4*)(rowp + bj * 128) = pack8(acc[ai][bj][m][0] * sc, acc[ai][bj][m][1] * sc); }
        } else if (pn < 13) {
            bf16_t* base = poolin + (pn - 9) * 256 + cw;
#pragma unroll
            for (int ai = 0; ai < 2; ++ai)
#pragma unroll
                for (int m = 0; m < 4; ++m) { bf16_t* rowp = base + (size_t)(row0 + ai * 128 + m * 16) * DM;
#pragma unroll
                    for (int bj = 0; bj < 2; ++bj) *(u32x4*)(rowp + bj * 128) = pack8(acc[ai][bj][m][0], acc[ai][bj][m][1]); }
        } else {
            bf16_t* base = (pn < 17 ? sga : sgb) + ((pn - 13) & 3) * 256 + cw;
#pragma unroll
            for (int ai = 0; ai < 2; ++ai)
#pragma unroll
                for (int m = 0; m < 4; ++m) { bf16_t* rowp = base + (size_t)(row0 + ai * 128 + m * 16) * DM;
#pragma unroll
                    for (int bj = 0; bj < 2; ++bj) { f32x4 v0 = acc[ai][bj][m][0], v1 = acc[ai][bj][m][1];
#pragma unroll
                        for (int j = 0; j < 4; ++j) { v0[j] = fast_sigmoid(v0[j]); v1[j] = fast_sigmoid(v1[j]); }
                        *(u32x4*)(rowp + bj * 128) = pack8(v0, v1); } }
        }
    }
};
struct EpiPg {
    static constexpr int HOOK_T = -1;
    bf16_t* out; const float* scale; int ld;
    __device__ __forceinline__ void operator()(const f32x4 (&acc)[2][2][4][2], const Unit& u, int wr, int wc, int fr, int fq) const {
        const int row0 = u.pm * 256 + wr * 64 + fr, col0 = u.pn * 256 + wc * 32 + 8 * fq;
        f32x4 sv[2][2];
#pragma unroll
        for (int bj = 0; bj < 2; ++bj) { sv[bj][0] = *(const f32x4*)(scale + col0 + bj * 128); sv[bj][1] = *(const f32x4*)(scale + col0 + bj * 128 + 4); }
#pragma unroll
        for (int ai = 0; ai < 2; ++ai)
#pragma unroll
            for (int m = 0; m < 4; ++m) { bf16_t* rowp = out + (size_t)(row0 + ai * 128 + m * 16) * ld + col0;
#pragma unroll
                for (int bj = 0; bj < 2; ++bj) *(u32x4*)(rowp + bj * 128) = pack8(acc[ai][bj][m][0] * sv[bj][0], acc[ai][bj][m][1] * sv[bj][1]); }
    }
};
__device__ __forceinline__ void unpack8(const u32x4 w, f32x4& a, f32x4& b) {
    a[0] = __uint_as_float(w.x << 16); a[1] = __uint_as_float(w.x & 0xffff0000u); a[2] = __uint_as_float(w.y << 16); a[3] = __uint_as_float(w.y & 0xffff0000u);
    b[0] = __uint_as_float(w.z << 16); b[1] = __uint_as_float(w.z & 0xffff0000u); b[2] = __uint_as_float(w.w << 16); b[3] = __uint_as_float(w.w & 0xffff0000u);
}
struct EpiMerge {
    static constexpr int HOOK_T = 4;
    bf16_t* merged; const bf16_t* sga; const bf16_t* sgb;
    __device__ __forceinline__ void hook(f32x4 (&acc)[2][2][4][2], const Unit& u, int wr, int wc, int fr, int fq) const {
        const unsigned loff = (unsigned)(((wr * 64 + fr) * DM + wc * 32 + 8 * fq) * 2);
        const size_t tb = ((size_t)u.pm * 256 * DM + (size_t)u.pn * 256) * 2;
#pragma unroll
        for (int ai = 0; ai < 2; ++ai)
#pragma unroll
            for (int m = 0; m < 4; ++m) { const char* pa = (const char*)sga + tb + (size_t)((ai * 128 + m * 16) * DM) * 2; const char* pb = (const char*)sgb + tb + (size_t)((ai * 128 + m * 16) * DM) * 2;
                asm volatile("" : "+s"(pa), "+s"(pb));
#pragma unroll
                for (int bj = 0; bj < 2; ++bj) { f32x4 a0, a1, b0, b1; unpack8(*(const u32x4*)(pa + loff + bj * 256), a0, a1); unpack8(*(const u32x4*)(pb + loff + bj * 256), b0, b1);
#pragma unroll
                    for (int j = 0; j < 4; ++j) { acc[ai][bj][m][0][j] *= a0[j] * __builtin_amdgcn_rcpf(fmaxf(b0[j], 1e-30f)); acc[ai][bj][m][1][j] *= a1[j] * __builtin_amdgcn_rcpf(fmaxf(b1[j], 1e-30f)); } }
                asm volatile("" ::: "memory"); }
    }
    __device__ __forceinline__ void operator()(const f32x4 (&acc)[2][2][4][2], const Unit& u, int wr, int wc, int fr, int fq) const {
        const int row0 = u.pm * 256 + wr * 64 + fr, col0 = u.pn * 256 + wc * 32 + 8 * fq;
#pragma unroll
        for (int ai = 0; ai < 2; ++ai)
#pragma unroll
            for (int m = 0; m < 4; ++m) { const size_t off = (size_t)(row0 + ai * 128 + m * 16) * DM + col0;
#pragma unroll
                for (int bj = 0; bj < 2; ++bj) { f32x4 g0, g1; unpack8(*(const u32x4*)(sgb + off + bj * 128), g0, g1);
                    *(u32x4*)(merged + off + bj * 128) = pack8(acc[ai][bj][m][0] * g0, acc[ai][bj][m][1] * g1); }
                asm volatile("" ::: "memory"); }
    }
};
struct EpiRes {
    static constexpr int HOOK_T = -1;
    float* out; const float* res; const float* modv; int gate_off;
    __device__ __forceinline__ void operator()(const f32x4 (&acc)[2][2][4][2], const Unit& u, int wr, int wc, int fr, int fq) const {
        const int row0 = u.pm * 256 + wr * 64 + fr, col0 = u.pn * 256 + wc * 32 + 8 * fq;
        const float* gp = modv + (size_t)(u.pm >> 3) * NMOD + gate_off + col0;
        f32x4 gv[2][2];
#pragma unroll
        for (int bj = 0; bj < 2; ++bj) { gv[bj][0] = *(const f32x4*)(gp + bj * 128); gv[bj][1] = *(const f32x4*)(gp + bj * 128 + 4); }
#pragma unroll
        for (int ai = 0; ai < 2; ++ai)
#pragma unroll
            for (int m = 0; m < 4; ++m) { const size_t off = (size_t)(row0 + ai * 128 + m * 16) * DM + col0;
#pragma unroll
                for (int bj = 0; bj < 2; ++bj) { const f32x4 r0 = *(const f32x4*)(res + off + bj * 128), r1 = *(const f32x4*)(res + off + bj * 128 + 4);
                    *(f32x4*)(out + off + bj * 128) = r0 * ALPHA + acc[ai][bj][m][0] * gv[bj][0]; *(f32x4*)(out + off + bj * 128 + 4) = r1 * ALPHA + acc[ai][bj][m][1] * gv[bj][1]; }
                asm volatile("" ::: "memory"); }
    }
};
struct EpiGu {
    static constexpr int HOOK_T = -1;
    bf16_t* act;
    __device__ __forceinline__ void operator()(const f32x4 (&acc)[2][2][4][2], const Unit& u, int wr, int wc, int fr, int fq) const {
        const int row0 = u.pm * 256 + wr * 64 + fr, col0 = u.pn * 128 + wc * 32 + 8 * fq;
#pragma unroll
        for (int ai = 0; ai < 2; ++ai)
#pragma unroll
            for (int m = 0; m < 4; ++m) { f32x4 v0, v1;
#pragma unroll
                for (int j = 0; j < 4; ++j) { const float g0 = acc[ai][0][m][0][j], g1 = acc[ai][0][m][1][j];
                    v0[j] = g0 * fast_sigmoid(g0) * acc[ai][1][m][0][j]; v1[j] = g1 * fast_sigmoid(g1) * acc[ai][1][m][1][j]; }
                *(u32x4*)(act + (size_t)(row0 + ai * 128 + m * 16) * DFF + col0) = pack8(v0, v1); }
    }
};

constexpr int QS_OFF = 0, KS_OFF = 128 * 144, VS_OFF = KS_OFF + 256 * 144, ATT_ROWB = 144;
__device__ __forceinline__ void attn_unit(LAS unsigned char* lds, const bf16_t* QKV, bf16_t* ATTO, float* LSE, int unit, int tid, int wave, int lane) {
    const int rn = unit & 15, hs = (unit >> 4) & 3, bg = unit >> 6, g = bg % 3, b = bg / 3;
    const int sh = 2 * g, L = 2048 >> sh, nbs = 4 - sh;
    const int r = rn >> nbs, n = rn & ((1 << nbs) - 1);
    const size_t gbase = (size_t)g * ((size_t)T * 256);
    const int rowbase = b * 2048 + r * L;
    const bf16_t* Qg = QKV + gbase + (size_t)(rowbase + n * 128) * 256 + hs * 64;
    const bf16_t* Kg = QKV + (size_t)T * 768 + gbase + (size_t)rowbase * 256 + hs * 64;
    const bf16_t* Vg = QKV + 2 * (size_t)T * 768 + gbase + (size_t)rowbase * 256 + hs * 64;
    u32x4 rq[2], rk[4], rv[4];
#pragma unroll
    for (int i = 0; i < 2; ++i) { const int c = tid + 512 * i, row = c >> 3, part = c & 7; rq[i] = *(const u32x4*)(Qg + (size_t)row * 256 + part * 8); }
#pragma unroll
    for (int i = 0; i < 4; ++i) { const int c = tid + 512 * i, j = c >> 3, part = c & 7; int ik = n * 128 - 128 + j; if (ik < 0) ik += 128;
        rk[i] = *(const u32x4*)(Kg + (size_t)ik * 256 + part * 8); rv[i] = *(const u32x4*)(Vg + (size_t)ik * 256 + part * 8); }
    __syncthreads();
#pragma unroll
    for (int i = 0; i < 2; ++i) { const int c = tid + 512 * i, row = c >> 3, part = c & 7; *(LAS u32x4*)(lds + QS_OFF + row * ATT_ROWB + part * 16) = rq[i]; }
#pragma unroll
    for (int i = 0; i < 4; ++i) { const int c = tid + 512 * i, j = c >> 3, part = c & 7;
        *(LAS u32x4*)(lds + KS_OFF + j * ATT_ROWB + part * 16) = rk[i]; *(LAS u32x4*)(lds + VS_OFF + j * ATT_ROWB + part * 16) = rv[i]; }
    __syncthreads();
    const int fr = lane & 15, fq = lane >> 4;
    const int qrow = 16 * wave + fr, ks = (wave == 7) ? 96 : 16 * wave;
    bf16x8 qf[2];
#pragma unroll
    for (int k = 0; k < 2; ++k) qf[k] = *(const LAS bf16x8*)(lds + QS_OFF + qrow * ATT_ROWB + (32 * k + fq * 8) * 2);
    f32x4 sc[10];
#pragma unroll
    for (int kt = 0; kt < 10; ++kt) { f32x4 a = (f32x4){0.f, 0.f, 0.f, 0.f};
#pragma unroll
        for (int k = 0; k < 2; ++k) { const bf16x8 kf = *(const LAS bf16x8*)(lds + KS_OFF + (ks + 16 * kt + fr) * ATT_ROWB + (32 * k + fq * 8) * 2);
            a = __builtin_amdgcn_mfma_f32_16x16x32_bf16(kf, qf[k], a, 0, 0, 0); }
        sc[kt] = a; }
    const int hidx = g * 4 + hs;
    const float slope = hidx < 8 ? exp2f(-0.5f * (float)(hidx + 1)) : exp2f(-(float)(hidx - 3));
    const float LOG2E = 1.4426950408889634f;
    const float sl2 = slope * (float)(1 << sh) * LOG2E;
    float mx = -INFINITY;
#pragma unroll
    for (int kt = 0; kt < 10; ++kt)
#pragma unroll
        for (int j = 0; j < 4; ++j) { const int kj = ks + 16 * kt + 4 * fq + j, diff = 128 + qrow - kj;
            const bool valid = (diff >= 0) && (diff <= 128) && (n > 0 || kj >= 128);
            const float v = valid ? sc[kt][j] * LOG2E - sl2 * (float)diff : -INFINITY; sc[kt][j] = v; mx = fmaxf(mx, v); }
    mx = fmaxf(mx, __shfl_xor(mx, 16)); mx = fmaxf(mx, __shfl_xor(mx, 32));
    float l = 0.f;
#pragma unroll
    for (int kt = 0; kt < 10; ++kt)
#pragma unroll
        for (int j = 0; j < 4; ++j) { const float p = exp2f(sc[kt][j] - mx); sc[kt][j] = p; l += p; }
    l += __shfl_xor(l, 16); l += __shfl_xor(l, 32);
    bf16x8 pf[5];
#pragma unroll
    for (int pp = 0; pp < 5; ++pp) { const u32x4 w = pack8(sc[2 * pp], sc[2 * pp + 1]); pf[pp] = __builtin_bit_cast(bf16x8, w); }
    const float rl = 1.0f / l;
    const int q4 = fr >> 2, p4 = fr & 3;
    const int t = b * 2048 + ((n * 128 + qrow) << sh) + r;
    bf16_t* orow = ATTO + gbase + (size_t)t * 256 + hs * 64 + 4 * fq;
#pragma unroll
    for (int dt = 0; dt < 4; ++dt) { f32x4 o = (f32x4){0.f, 0.f, 0.f, 0.f};
#pragma unroll
        for (int pp = 0; pp < 5; ++pp) {
            const s16x4 lo = __builtin_amdgcn_ds_read_tr16_b64_v4i16((LAS s16x4*)(lds + VS_OFF + (ks + 32 * pp + 4 * fq + q4) * ATT_ROWB + (16 * dt + 4 * p4) * 2));
            const s16x4 hi = __builtin_amdgcn_ds_read_tr16_b64_v4i16((LAS s16x4*)(lds + VS_OFF + (ks + 32 * pp + 16 + 4 * fq + q4) * ATT_ROWB + (16 * dt + 4 * p4) * 2));
            const bf16x8 vf = __builtin_shufflevector(lo, hi, 0, 1, 2, 3, 4, 5, 6, 7);
            o = __builtin_amdgcn_mfma_f32_16x16x32_bf16(vf, pf[pp], o, 0, 0, 0); }
        u32x2 w; w.x = cvt_pk_bf16(o[0] * rl, o[1] * rl); w.y = cvt_pk_bf16(o[2] * rl, o[3] * rl);
        *(u32x2*)(orow + 16 * dt) = w; }
    if (fq == 0) LSE[((size_t)g * T + t) * 4 + hs] = (mx + log2f(l)) * 0.6931471805599453f;
}

template <int W>
__device__ __forceinline__ void pool_item(const bf16_t* POOLIN, bf16_t* PM, int pair, int g, int lane) {
    const int tok = pair * 2 + (lane >> 5), s = tok & 2047, col = g * 256 + (lane & 31) * 8;
    const bf16_t* p = POOLIN + (size_t)tok * DM + col;
    u32x4 v[W];
#pragma unroll
    for (int i = 0; i < W; ++i) { const int back = (i <= s) ? i : 0; v[i] = *(const u32x4*)(p - (size_t)back * DM); }
    f32x4 s0 = (f32x4){0.f, 0.f, 0.f, 0.f}, s1 = s0, u0, u1;
#pragma unroll
    for (int i = 0; i < W; ++i) { f32x4 a, bb; unpack8(v[i], a, bb); if (i == 0) { u0 = a; u1 = bb; } if (i <= s) { s0 += a; s1 += bb; } }
    const float rc = 1.0f / (float)((s + 1) < W ? (s + 1) : W);
    *(u32x4*)(PM + (size_t)tok * DM + col) = pack8(s0 * rc - u0, s1 * rc - u1);
}


#define XB_TMO      128
#define XB_XCNT(j)  (256  + 64 * (j))
#define XB_XSUB(j)  (1280 + 64 * (j))
#define XB_XGEN(j)  (2304 + 64 * (j))
#define XB_TOP      3328
#define XB_TOPGEN   3392
#define XCD_BAR_WORDS 3456
#define XB_SPIN_CAP (1u << 18)
__device__ __forceinline__ unsigned xb_ld(unsigned* p)              { return __hip_atomic_load(p, __ATOMIC_RELAXED, __HIP_MEMORY_SCOPE_AGENT); }
__device__ __forceinline__ unsigned xb_add(unsigned* p, unsigned v) { return __hip_atomic_fetch_add(p, v, __ATOMIC_RELAXED, __HIP_MEMORY_SCOPE_AGENT); }
__device__ __forceinline__ unsigned xb_xcc_id() { return (unsigned)__builtin_amdgcn_s_getreg((3 << 11) | 20) & 0xFu; }
#define XB_SPIN(cond, bar) do { unsigned _sp = 0; while (cond) { __builtin_amdgcn_s_sleep(1); \
    if ((++_sp & 255u) == 0u) { if (xb_ld(&(bar)[XB_TMO])) break; if (_sp > XB_SPIN_CAP) { atomicAdd(&(bar)[XB_TMO], 1u); break; } } } } while (0)
struct XcdBarrier { unsigned* bar; unsigned x; volatile LAS unsigned* st; };
__device__ __forceinline__ void xcd_barrier_complete(unsigned* bar, unsigned x, unsigned& nloc, unsigned& nx) {
    const unsigned G = gridDim.x * gridDim.y * gridDim.z;
    unsigned sum, cnt, mine, sp = 0u;
    for (;;) {
        sum = 0u; cnt = 0u; mine = 0u;
#pragma unroll
        for (unsigned j = 0; j < 16; ++j) { const unsigned c = xb_ld(&bar[XB_XCNT(j)]); sum += c; cnt += (c > 0u) ? 1u : 0u; mine = (j == x) ? c : mine; }
        if (sum == G) break;
        __builtin_amdgcn_s_sleep(1);
        if ((++sp & 255u) == 0u) { if (xb_ld(&bar[XB_TMO])) break; if (sp > XB_SPIN_CAP) { atomicAdd(&bar[XB_TMO], 1u); break; } }
    }
    nloc = mine > 0u ? mine : 1u; nx = cnt > 0u ? cnt : 1u;
}
__device__ __forceinline__ void xcd_barrier(const XcdBarrier& b) {
    asm volatile("s_waitcnt vmcnt(0)" ::: "memory");
    __syncthreads();
    if (threadIdx.x == 0) {
        unsigned* bar = b.bar;
        __builtin_amdgcn_s_waitcnt(0);
        unsigned nloc = b.st[0], nx = b.st[1];
        if (nloc == 0u) { xcd_barrier_complete(bar, b.x, nloc, nx); b.st[0] = nloc; b.st[1] = nx; }
        const unsigned old = xb_add(&bar[XB_XSUB(b.x)], 1u);
        const unsigned gen = old / nloc;
        if (old + 1u == (gen + 1u) * nloc) {
            __builtin_amdgcn_fence(__ATOMIC_RELEASE, "agent");
            asm volatile("s_waitcnt vmcnt(0)" ::: "memory");
            const unsigned og = xb_add(&bar[XB_TOP], 1u);
            const unsigned tg = og / nx;
            if (og + 1u == (tg + 1u) * nx) xb_add(&bar[XB_TOPGEN], 1u);
            else XB_SPIN(xb_ld(&bar[XB_TOPGEN]) == tg, bar);
            __builtin_amdgcn_fence(__ATOMIC_ACQUIRE, "agent");
            xb_add(&bar[XB_XGEN(b.x)], 1u);
            asm volatile("s_waitcnt vmcnt(0)" ::: "memory");
        } else {
            XB_SPIN(xb_ld(&bar[XB_XGEN(b.x)]) == gen, bar);
            __builtin_amdgcn_fence(__ATOMIC_ACQUIRE, "agent");
            asm volatile("s_waitcnt vmcnt(0)" ::: "memory");
        }
    }
    __syncthreads();
}
constexpr int MISC_OFF = 131072 + 320;
constexpr int BAR_WORD0 = 1024;

struct Args {
    const float* x; const float* c; const float* w_ada; const float* b_ada; const float* w_in; const float* w_branch_att; const float* w_pool_group; const float* pool_scale;
    const float* w_branch_pool; const float* w_out; const float* ln1_g; const float* ln1_b; const float* w_gate; const float* w_up; const float* w_down; const float* ln2_g; const float* ln2_b;
    float* out; unsigned char* ws;
};

#define CAS __attribute__((address_space(4)))
typedef const CAS Args* ArgsP;
__device__ __forceinline__ ArgsP fresh_args() { unsigned long long p = (unsigned long long)__builtin_amdgcn_kernarg_segment_ptr(); asm volatile("" : "+s"(p)); return (ArgsP)p; }

__device__ __forceinline__ void transpose_item(const float* W, int N, int k0, int n0, bf16_t* WT, int ldt, int drow0, LAS float* scr, int lane) {
#pragma unroll 8
    for (int i = 0; i < 32; ++i) { const int kk = 2 * i + (lane >> 5); scr[kk * 33 + (lane & 31)] = W[(size_t)(k0 + kk) * N + n0 + (lane & 31)]; }
    asm volatile("s_waitcnt lgkmcnt(0)" ::: "memory");
    const int c = lane & 7;
#pragma unroll
    for (int j = 0; j < 4; ++j) { const int n = (lane >> 3) + 8 * j; const LAS float* s = scr + (8 * c) * 33 + n;
        u32x4 o; o.x = cvt_pk_bf16(s[0 * 33], s[1 * 33]); o.y = cvt_pk_bf16(s[2 * 33], s[3 * 33]); o.z = cvt_pk_bf16(s[4 * 33], s[5 * 33]); o.w = cvt_pk_bf16(s[6 * 33], s[7 * 33]);
        *(u32x4*)(WT + (size_t)(drow0 + n) * ldt + k0 + 8 * c) = o; }
    asm volatile("s_waitcnt lgkmcnt(0)" ::: "memory");
}

__global__ void __launch_bounds__(NTHR, 2) fwd_megakernel(Args a) {
    extern __shared__ __attribute__((aligned(16))) unsigned char lds_raw[];
    cg::grid_group grid = cg::this_grid();
    LAS unsigned char* lds = (LAS unsigned char*)lds_raw;
    const int G = gridDim.x, NGW = G * NWAVES;
    if (threadIdx.x < 32) ((LAS unsigned*)(lds + MISC_OFF))[threadIdx.x] = 0u;
    __syncthreads();
    grid.sync();
    if (threadIdx.x == 0) (void)xb_add((unsigned*)(fresh_args()->ws) + BAR_WORD0 + XB_XCNT(xb_xcc_id()), 1u);
#define GRID_BAR() do { XcdBarrier b_; b_.bar = (unsigned*)(fresh_args()->ws) + BAR_WORD0; b_.x = xb_xcc_id(); b_.st = (volatile LAS unsigned*)(lds + MISC_OFF) + 8; xcd_barrier(b_); } while (0)
#define FRESH_IDS() const int tid = fresh_tid(), lane = tid & 63, wave = __builtin_amdgcn_readfirstlane(tid >> 6), gw = blockIdx.x * NWAVES + wave; (void)lane; (void)gw
#define PTRS() ArgsP ap = fresh_args(); unsigned char* ws = ap->ws; (void)ws
#define Win_t ((bf16_t*)(ws + WS_WIN))
#define Wcat_t ((bf16_t*)(ws + WS_WCAT))
#define Wpg_t ((bf16_t*)(ws + WS_WPG))
#define Wo_t ((bf16_t*)(ws + WS_WO))
#define Wgu_t ((bf16_t*)(ws + WS_WGU))
#define Wd_t ((bf16_t*)(ws + WS_WD))
#define MOD ((float*)(ws + WS_MOD))
#define LSE ((float*)(ws + WS_LSE))
#define H ((bf16_t*)(ws + WS_B))
#define PM H
#define MERGED H
#define H2 H
#define QKV ((bf16_t*)(ws + WS_C))
#define APK ((bf16_t*)(ws + WS_C))
#define X1 ((float*)(ws + WS_C))
#define POOLIN ((bf16_t*)(ws + WS_D))
#define ACT POOLIN
#define SGA ((bf16_t*)(ws + WS_E))
#define SGB (SGA + (size_t)T * DM)
#define Y ((float*)(ws + WS_E))
#define ATTO ((bf16_t*)(ws + WS_F))

    if (blockIdx.x < 192) {
        FRESH_IDS(); PTRS();
        LAS float* sl = (LAS float*)lds;
        LAS float* red = (LAS float*)(lds + 65536);
        for (int idx = tid; idx < NB * DM; idx += NTHR) { const int b = idx >> 10, k = idx & 1023; const float v = ap->c[idx]; sl[k * 16 + b] = v / (1.0f + __expf(-v)); }
        __syncthreads();
        const int n0 = blockIdx.x * 32, col = lane & 31, kh = lane >> 5;
        float accm[16];
#pragma unroll
        for (int b = 0; b < 16; ++b) accm[b] = 0.f;
        const float* wp = ap->w_ada + (size_t)(wave * 128 + kh) * NMOD + n0 + col;
#pragma unroll 8
        for (int j = 0; j < 64; ++j) { const float w = wp[(size_t)(2 * j) * NMOD]; const int k = wave * 128 + 2 * j + kh;
            const LAS f32x4* s4 = (const LAS f32x4*)(sl + k * 16);
#pragma unroll
            for (int q = 0; q < 4; ++q) { const f32x4 sv = s4[q];
#pragma unroll
                for (int e = 0; e < 4; ++e) accm[q * 4 + e] += sv[e] * w; } }
#pragma unroll
        for (int b = 0; b < 16; ++b) { accm[b] += __shfl_xor(accm[b], 32); }
        if (kh == 0) {
#pragma unroll
            for (int b = 0; b < 16; ++b) red[(wave * 16 + b) * 32 + col] = accm[b]; }
        __syncthreads();
        { const int b = tid >> 5, cc = tid & 31; float v = ap->b_ada[n0 + cc];
#pragma unroll
          for (int w = 0; w < 8; ++w) v += red[(w * 16 + b) * 32 + cc];
          MOD[(size_t)b * NMOD + n0 + cc] = v; }
        __syncthreads();
    }
    {
        FRESH_IDS(); PTRS();
        LAS float* scr = (LAS float*)(lds + wave * 16384);
        for (int it = gw; it < 8192; it += NGW) {
            int r = it;
            if (r < 2688) { const int kb = r / 168, nb = r % 168; transpose_item(ap->w_in, INW, kb * 64, nb * 32, Win_t, DM, nb * 32, scr, lane); continue; } r -= 2688;
            if (r < 128) { const int kb = r / 32, nb = r % 32; transpose_item(ap->w_branch_att, DM, kb * 64, nb * 32, Wcat_t, 1280, nb * 32, scr, lane); continue; } r -= 128;
            if (r < 128) { const int gg = r >> 5, q = r & 31, kb = q / 8, nb = q % 8; transpose_item(ap->w_pool_group + gg * 65536, 256, kb * 64, nb * 32, Wpg_t + gg * 65536, 256, nb * 32, scr, lane); continue; } r -= 128;
            if (r < 512) { const int kb = r / 32, nb = r % 32; transpose_item(ap->w_branch_pool, DM, kb * 64, nb * 32, Wcat_t + 256, 1280, nb * 32, scr, lane); continue; } r -= 512;
            if (r < 512) { const int kb = r / 32, nb = r % 32; transpose_item(ap->w_out, DM, kb * 64, nb * 32, Wo_t, DM, nb * 32, scr, lane); continue; } r -= 512;
            if (r < 1408) { const int kb = r / 88, nb = r % 88, n0 = nb * 32; transpose_item(ap->w_gate, DFF, kb * 64, n0, Wgu_t, DM, (n0 >> 7) * 256 + (n0 & 127), scr, lane); continue; } r -= 1408;
            if (r < 1408) { const int kb = r / 88, nb = r % 88, n0 = nb * 32; transpose_item(ap->w_up, DFF, kb * 64, n0, Wgu_t, DM, (n0 >> 7) * 256 + 128 + (n0 & 127), scr, lane); continue; } r -= 1408;
            { const int kb = r / 32, nb = r % 32; transpose_item(ap->w_down, DM, kb * 64, nb * 32, Wd_t, DFF, nb * 32, scr, lane); }
        }
    }
    GRID_BAR();

    { FRESH_IDS(); PTRS();
    for (int m = gw; m < T; m += NGW) {
        const float* mr = MOD + (size_t)(m >> 11) * NMOD;
        const f32x4* xr = (const f32x4*)(ap->x + (size_t)m * DM) + lane;
        unsigned long long* o8 = (unsigned long long*)(H + (size_t)m * DM) + lane;
#pragma unroll
        for (int j = 0; j < 4; ++j) { const f32x4 v = xr[64 * j]; const f32x4 sh = *((const f32x4*)(mr) + lane + 64 * j), sc = *((const f32x4*)(mr + 1024) + lane + 64 * j);
            const f32x4 h = v * (sc + 1.0f) + sh;
            o8[64 * j] = (unsigned long long)cvt_pk_bf16(h[0], h[1]) | ((unsigned long long)cvt_pk_bf16(h[2], h[3]) << 32); }
    } }
    GRID_BAR();

    { PTRS(); pg8::Gemm g{H, Win_t, DM, DM, DM, 0}; pg8::StaticOrder S; S.init(T, INW, G, (int)blockIdx.x);
      EpiProj E{QKV, POOLIN, SGA, SGB}; pg8::gemm_phase(lds, g, S, E); }
    GRID_BAR();

    { FRESH_IDS(); PTRS();
    for (int u = blockIdx.x; u < 3072; u += G) attn_unit(lds, QKV, ATTO, LSE, u, tid, wave, lane); }
    { FRESH_IDS(); PTRS();
    for (int k = 0; k < 32; ++k) {
        const int gsel = (k + gw) & 3, pair = gw + NGW * (k >> 2);
        if (pair < T / 2) {
            if (gsel == 0) pool_item<2>(POOLIN, PM, pair, 0, lane); else if (gsel == 1) pool_item<4>(POOLIN, PM, pair, 1, lane);
            else if (gsel == 2) pool_item<8>(POOLIN, PM, pair, 2, lane); else pool_item<16>(POOLIN, PM, pair, 3, lane);
        }
    } }
    __syncthreads();
    GRID_BAR();

    { PTRS(); pg8::Gemm g{PM, Wpg_t, DM, 256, 256, 256}; pg8::StaticOrder S; S.init(T, DM, G, (int)blockIdx.x);
      EpiPg E{APK + 256, ap->pool_scale, 1280}; pg8::gemm_phase(lds, g, S, E); }
    { FRESH_IDS(); PTRS();
    for (int m = gw; m < T; m += NGW) {
        const int hs = lane >> 4;
        const float l0 = LSE[((size_t)0 * T + m) * 4 + hs], l1 = LSE[((size_t)1 * T + m) * 4 + hs], l2 = LSE[((size_t)2 * T + m) * 4 + hs];
        const float mxl = fmaxf(l0, fmaxf(l1, l2));
        const float e0 = __expf(l0 - mxl), e1 = __expf(l1 - mxl), e2 = __expf(l2 - mxl), rs = 1.0f / (e0 + e1 + e2);
        const float w0 = e0 * rs, w1 = e1 * rs, w2 = e2 * rs;
        const u32x2 a0 = *((const u32x2*)(ATTO + (size_t)m * 256) + lane), a1 = *((const u32x2*)(ATTO + (size_t)T * 256 + (size_t)m * 256) + lane), a2 = *((const u32x2*)(ATTO + 2 * (size_t)T * 256 + (size_t)m * 256) + lane);
        float o[4];
        o[0] = w0 * __uint_as_float(a0.x << 16) + w1 * __uint_as_float(a1.x << 16) + w2 * __uint_as_float(a2.x << 16);
        o[1] = w0 * __uint_as_float(a0.x & 0xffff0000u) + w1 * __uint_as_float(a1.x & 0xffff0000u) + w2 * __uint_as_float(a2.x & 0xffff0000u);
        o[2] = w0 * __uint_as_float(a0.y << 16) + w1 * __uint_as_float(a1.y << 16) + w2 * __uint_as_float(a2.y << 16);
        o[3] = w0 * __uint_as_float(a0.y & 0xffff0000u) + w1 * __uint_as_float(a1.y & 0xffff0000u) + w2 * __uint_as_float(a2.y & 0xffff0000u);
        u32x2 w; w.x = cvt_pk_bf16(o[0], o[1]); w.y = cvt_pk_bf16(o[2], o[3]);
        *((u32x2*)(APK + (size_t)m * 1280) + lane) = w;
    } }
    GRID_BAR();

    { PTRS(); pg8::Gemm g{APK, Wcat_t, 1280, 1280, 1280, 0}; pg8::StaticOrder S; S.init(T, DM, G, (int)blockIdx.x);
      EpiMerge E{MERGED, SGA, SGB}; pg8::gemm_phase(lds, g, S, E); }
    GRID_BAR();

    { PTRS(); pg8::Gemm g{MERGED, Wo_t, DM, DM, DM, 0}; pg8::StaticOrder S; S.init(T, DM, G, (int)blockIdx.x);
      EpiRes E{Y, ap->x, MOD, 2048}; pg8::gemm_phase(lds, g, S, E); }
    GRID_BAR();

    { FRESH_IDS(); PTRS();
    for (int m = gw; m < T; m += NGW) {
        const float* mr = MOD + (size_t)(m >> 11) * NMOD;
        const f32x4* yr = (const f32x4*)(Y + (size_t)m * DM) + lane;
        f32x4 v[4]; float s = 0.f;
#pragma unroll
        for (int j = 0; j < 4; ++j) { v[j] = yr[64 * j]; s += (v[j][0] + v[j][1]) + (v[j][2] + v[j][3]); }
        const float mean = wave_sum(s) * (1.f / DM); float s2 = 0.f;
#pragma unroll
        for (int j = 0; j < 4; ++j) { v[j] = v[j] - mean; s2 += (v[j][0] * v[j][0] + v[j][1] * v[j][1]) + (v[j][2] * v[j][2] + v[j][3] * v[j][3]); }
        const float rstd = 1.f / sqrtf(wave_sum(s2) * (1.f / DM) + LN_EPS);
        f32x4* xo = (f32x4*)(X1 + (size_t)m * DM) + lane;
        unsigned long long* o8 = (unsigned long long*)(H2 + (size_t)m * DM) + lane;
#pragma unroll
        for (int j = 0; j < 4; ++j) { const f32x4 gg = *((const f32x4*)ap->ln1_g + lane + 64 * j), bb = *((const f32x4*)ap->ln1_b + lane + 64 * j);
            const f32x4 x1 = v[j] * rstd * gg + bb; xo[64 * j] = x1;
            const f32x4 sh = *((const f32x4*)(mr + 3072) + lane + 64 * j), sc = *((const f32x4*)(mr + 4096) + lane + 64 * j);
            const f32x4 h = x1 * (sc + 1.0f) + sh;
            o8[64 * j] = (unsigned long long)cvt_pk_bf16(h[0], h[1]) | ((unsigned long long)cvt_pk_bf16(h[2], h[3]) << 32); }
    } }
    GRID_BAR();

    { PTRS(); pg8::Gemm g{H2, Wgu_t, DM, DM, DM, 0}; pg8::StaticOrder S; S.init(T, 2 * DFF, G, (int)blockIdx.x);
      EpiGu E{ACT}; pg8::gemm_phase(lds, g, S, E); }
    GRID_BAR();

    { PTRS(); pg8::Gemm g{ACT, Wd_t, DFF, DFF, DFF, 0}; pg8::StaticOrder S; S.init(T, DM, G, (int)blockIdx.x);
      EpiRes E{ap->out, X1, MOD, 5120}; pg8::gemm_phase(lds, g, S, E); }
    GRID_BAR();

    { FRESH_IDS(); PTRS();
    for (int m = gw; m < T; m += NGW) {
        f32x4* yr = (f32x4*)(ap->out + (size_t)m * DM) + lane;
        f32x4 v[4]; float s = 0.f;
#pragma unroll
        for (int j = 0; j < 4; ++j) { v[j] = yr[64 * j]; s += (v[j][0] + v[j][1]) + (v[j][2] + v[j][3]); }
        const float mean = wave_sum(s) * (1.f / DM); float s2 = 0.f;
#pragma unroll
        for (int j = 0; j < 4; ++j) { v[j] = v[j] - mean; s2 += (v[j][0] * v[j][0] + v[j][1] * v[j][1]) + (v[j][2] * v[j][2] + v[j][3] * v[j][3]); }
        const float rstd = 1.f / sqrtf(wave_sum(s2) * (1.f / DM) + LN_EPS);
#pragma unroll
        for (int j = 0; j < 4; ++j) { const f32x4 gg = *((const f32x4*)ap->ln2_g + lane + 64 * j), bb = *((const f32x4*)ap->ln2_b + lane + 64 * j);
            yr[64 * j] = v[j] * rstd * gg + bb; }
    } }
}

extern "C" void kernel_launch(void* const* d_in, const int* in_sizes, int n_in, void* d_out, int out_size, void* d_ws, size_t ws_size, hipStream_t stream) {
    static int grid = 0;
    if (grid == 0) {
        if (n_in != 17 || in_sizes[0] != T * DM || out_size != T * DM || ws_size < WS_END) { fprintf(stderr, "kernel_launch: unexpected shapes / workspace (n_in %d, ws %zu)\n", n_in, ws_size); grid = -1; return; }
        int dev = 0, cus = 0, per_cu = 0;
        hipGetDevice(&dev); hipDeviceGetAttribute(&cus, hipDeviceAttributeMultiprocessorCount, dev);
        if (hipFuncSetAttribute((const void*)fwd_megakernel, hipFuncAttributeMaxDynamicSharedMemorySize, LDS_BYTES) != hipSuccess) { fprintf(stderr, "kernel_launch: hipFuncSetAttribute failed\n"); grid = -1; return; }
        if (hipOccupancyMaxActiveBlocksPerMultiprocessor(&per_cu, (const void*)fwd_megakernel, NTHR, LDS_BYTES) != hipSuccess || per_cu < 1) { fprintf(stderr, "kernel_launch: occupancy query says %d blocks per CU\n", per_cu); grid = -1; return; }
        grid = cus;
    }
    if (grid < 0) return;
    Args a{};
    a.x = (const float*)d_in[0]; a.c = (const float*)d_in[1]; a.w_ada = (const float*)d_in[2]; a.b_ada = (const float*)d_in[3]; a.w_in = (const float*)d_in[4];
    a.w_branch_att = (const float*)d_in[5]; a.w_pool_group = (const float*)d_in[6]; a.pool_scale = (const float*)d_in[7]; a.w_branch_pool = (const float*)d_in[8];
    a.w_out = (const float*)d_in[9]; a.ln1_g = (const float*)d_in[10]; a.ln1_b = (const float*)d_in[11]; a.w_gate = (const float*)d_in[12]; a.w_up = (const float*)d_in[13];
    a.w_down = (const float*)d_in[14]; a.ln2_g = (const float*)d_in[15]; a.ln2_b = (const float*)d_in[16];
    a.out = (float*)d_out; a.ws = (unsigned char*)d_ws;
    if (hipMemsetAsync(d_ws, 0, 65536, stream) != hipSuccess) { fprintf(stderr, "kernel_launch: hipMemsetAsync failed\n"); return; }
    void* args[] = {&a};
    hipError_t e = hipLaunchCooperativeKernel((const void*)fwd_megakernel, dim3(grid), dim3(NTHR), args, LDS_BYTES, stream);
    if (e != hipSuccess) fprintf(stderr, "kernel_launch: cooperative launch failed: %s (grid %d)\n", hipGetErrorString(e), grid);
}
```
